# Optimizing an MI355X kernel written in HIP

```python
import jax, jax.numpy as jnp
from jax import lax
import numpy as np

D_MODEL = 2048
BATCH = 4
SEQ = 8192
DEPTH = 1

CHUNK = 64
GMLP_BLOCK = 128
A_WIDTH = D_MODEL // 2
A_GROUPS = 8
A_HEAD = A_WIDTH // A_GROUPS
B_WIDTH = D_MODEL // 2
CONV_WIDTH = 31
D_FF = ((8 * D_MODEL // 3 + 255) // 256) * 256
LN_EPS = 1e-5
ALPHA = (2.0 * DEPTH) ** 0.25
BETA = (8.0 * DEPTH) ** -0.25
IN_COLS = 2 * A_WIDTH + 2 * B_WIDTH + 2 * D_MODEL

kernel_name = "hybrid_gmlp_conformer_conv_macaron_deepnorm"


def layer_norm(x, g, b):
    xf = x.astype(jnp.float32)
    mu = jnp.mean(xf, axis=-1, keepdims=True)
    var = jnp.mean(jnp.square(xf - mu), axis=-1, keepdims=True)
    y = (xf - mu) * lax.rsqrt(var + LN_EPS)
    return (y * g.astype(jnp.float32) + b.astype(jnp.float32)).astype(x.dtype)


def swiglu(x, w_gu, w_down):
    gate, up = jnp.split(x @ w_gu, 2, axis=-1)
    return (jax.nn.silu(gate) * up) @ w_down


def block_causal_mask(n):
    c = jnp.arange(n) // CHUNK
    return c[None, :] <= c[:, None]


def spatial_gating(u, v, ln_g, ln_b, w_s, b_s):
    bsz, seq, _ = v.shape
    v = layer_norm(v, ln_g, ln_b)
    nblk = seq // GMLP_BLOCK
    vb = v.reshape(bsz, nblk, GMLP_BLOCK, A_GROUPS, A_HEAD)
    w = jnp.where(block_causal_mask(GMLP_BLOCK)[None], w_s, jnp.zeros((), w_s.dtype))
    s = jnp.einsum('hij,bnjhd->bnihd', w, vb) + jnp.transpose(b_s)[None, None, :, :, None]
    return u * s.reshape(bsz, seq, A_WIDTH)


def conv_module(h, w_dw, b_dw, ln_g, ln_b):
    a, g = jnp.split(h, 2, axis=-1)
    z = a * jax.nn.sigmoid(g)
    z = lax.conv_general_dilated(
        z, w_dw[:, None, :], window_strides=(1,),
        padding=[(CONV_WIDTH - 1, 0)],
        dimension_numbers=('NWC', 'WIO', 'NWC'),
        feature_group_count=B_WIDTH) + b_dw
    z = layer_norm(z, ln_g, ln_b)
    return jax.nn.silu(z)


def setup_inputs(seed: int = 0) -> dict:
    key = jax.random.key(seed)
    ks = jax.random.split(key, 32)
    n = jax.random.normal
    L = DEPTH
    def gain(k, d):
        return 1.0 + 0.01 * n(k, (L, d), jnp.float32)
    def bias(k, shape):
        return 0.01 * n(k, (L,) + shape, jnp.float32)
    return {
        "x": n(ks[0], (BATCH, SEQ, D_MODEL), jnp.float32),
        "ffn1_w_gu": n(ks[1], (L, D_MODEL, 2 * D_FF), jnp.float32) * D_MODEL ** -0.5,
        "ffn1_w_down": n(ks[2], (L, D_FF, D_MODEL), jnp.float32) * (D_FF ** -0.5 * BETA),
        "ln1_g": gain(ks[3], D_MODEL),
        "ln1_b": bias(ks[4], (D_MODEL,)),
        "w_in": n(ks[5], (L, D_MODEL, IN_COLS), jnp.float32) * D_MODEL ** -0.5,
        "b_in": bias(ks[6], (IN_COLS,)),
        "sgu_ln_g": gain(ks[7], A_WIDTH),
        "sgu_ln_b": bias(ks[8], (A_WIDTH,)),
        "sgu_w_s": n(ks[9], (L, A_GROUPS, GMLP_BLOCK, GMLP_BLOCK), jnp.float32) * (0.5 * GMLP_BLOCK ** -0.5),
        "sgu_b_s": 1.0 + 0.01 * n(ks[10], (L, A_GROUPS, GMLP_BLOCK), jnp.float32),
        "w_a_proj": n(ks[11], (L, A_WIDTH, D_MODEL), jnp.float32) * (A_WIDTH ** -0.5 * BETA),
        "conv_w_dw": n(ks[12], (L, CONV_WIDTH, B_WIDTH), jnp.float32) * CONV_WIDTH ** -0.5,
        "conv_b_dw": bias(ks[13], (B_WIDTH,)),
        "conv_ln_g": gain(ks[14], B_WIDTH),
        "conv_ln_b": bias(ks[15], (B_WIDTH,)),
        "w_b_proj": n(ks[16], (L, B_WIDTH, D_MODEL), jnp.float32) * (B_WIDTH ** -0.5 * BETA),
        "w_out": n(ks[17], (L, D_MODEL, D_MODEL), jnp.float32) * (D_MODEL ** -0.5 * BETA),
        "ln2_g": gain(ks[18], D_MODEL),
        "ln2_b": bias(ks[19], (D_MODEL,)),
        "ffn2_w_gu": n(ks[20], (L, D_MODEL, 2 * D_FF), jnp.float32) * D_MODEL ** -0.5,
        "ffn2_w_down": n(ks[21], (L, D_FF, D_MODEL), jnp.float32) * (D_FF ** -0.5 * BETA),
        "ln3_g": gain(ks[22], D_MODEL),
        "ln3_b": bias(ks[23], (D_MODEL,)),
    }


def reference(x, ffn1_w_gu, ffn1_w_down, ln1_g, ln1_b, w_in, b_in, sgu_ln_g, sgu_ln_b,
              sgu_w_s, sgu_b_s, w_a_proj, conv_w_dw, conv_b_dw, conv_ln_g, conv_ln_b,
              w_b_proj, w_out, ln2_g, ln2_b, ffn2_w_gu, ffn2_w_down, ln3_g, ln3_b):
    for l in range(DEPTH):
        x = layer_norm(ALPHA * x + 0.5 * swiglu(x, ffn1_w_gu[l], ffn1_w_down[l]), ln1_g[l], ln1_b[l])

        proj = x @ w_in[l] + b_in[l]
        u_a, v_a, h_b, gate_logits = jnp.split(
            proj, [A_WIDTH, 2 * A_WIDTH, 2 * A_WIDTH + 2 * B_WIDTH], axis=-1)

        y_a = spatial_gating(jax.nn.gelu(u_a), jax.nn.gelu(v_a), sgu_ln_g[l], sgu_ln_b[l],
                             sgu_w_s[l], sgu_b_s[l]) @ w_a_proj[l]
        y_b = conv_module(h_b, conv_w_dw[l], conv_b_dw[l], conv_ln_g[l], conv_ln_b[l]) @ w_b_proj[l]

        g_a, g_b = jnp.split(jax.nn.sigmoid(gate_logits), 2, axis=-1)
        mix = (g_a * y_a + g_b * y_b) @ w_out[l]
        x = layer_norm(ALPHA * x + mix, ln2_g[l], ln2_b[l])

        x = layer_norm(ALPHA * x + 0.5 * swiglu(x, ffn2_w_gu[l], ffn2_w_down[l]), ln3_g[l], ln3_b[l])
    return x
```

```cpp
#include <hip/hip_runtime.h>
#include <hip/hip_cooperative_groups.h>
#include <cstdio>
#include <cstdint>
namespace cg = cooperative_groups;

#define LAS __attribute__((address_space(3)))
typedef unsigned short bf16_t;
typedef short bf16x8 __attribute__((ext_vector_type(8)));
typedef float f32x4 __attribute__((ext_vector_type(4)));
typedef float f32x2 __attribute__((ext_vector_type(2)));
typedef unsigned u32x4 __attribute__((ext_vector_type(4)));
typedef unsigned u32x2 __attribute__((ext_vector_type(2)));

constexpr int DM = 2048, MTOK = 4 * 8192, SEQ = 8192, FF = 5632, AW = 1024, INC = 8192;
constexpr float LN_EPS = 1e-5f, ALPHA = 1.189207115002721f;
constexpr int NWAVES = 8, NTHREADS = 512, LDS_BYTES = 147456;

constexpr size_t MiB = 1u << 20;
constexpr size_t WS_WGU1 = 0, WS_WD1 = 44 * MiB, WS_WIN = 66 * MiB, WS_WA = 98 * MiB, WS_WB = 102 * MiB, WS_WOUT = 106 * MiB, WS_WGU2 = 114 * MiB, WS_WD2 = 158 * MiB;
constexpr size_t WS_WSB = 180 * MiB, WS_STASH = 182 * MiB, WS_XB = 256 * MiB, WS_BIG = 384 * MiB, WS_BOUT = 832 * MiB, WS_END = 896 * MiB;
constexpr size_t WS_U = WS_BIG, WS_V = WS_BIG + 64 * MiB, WS_Z = WS_BIG + 128 * MiB, WS_G = WS_BIG + 192 * MiB, WS_H = WS_BIG;

__device__ __forceinline__ unsigned cvt_pk_bf16(float lo, float hi) { unsigned r; asm volatile("v_cvt_pk_bf16_f32 %0, %1, %2" : "=v"(r) : "v"(lo), "v"(hi)); return r; }
__device__ __forceinline__ float bf_lo(unsigned w) { return __uint_as_float(w << 16); }
__device__ __forceinline__ float bf_hi(unsigned w) { return __uint_as_float(w & 0xffff0000u); }
__device__ __forceinline__ float sigmoid_f(float y) { return __builtin_amdgcn_rcpf(1.0f + __builtin_amdgcn_exp2f(-1.4426950409f * y)); }
__device__ __forceinline__ float silu_f(float x) { return x * sigmoid_f(x); }
__device__ __forceinline__ float gelu_tanh_f(float x) { return x * sigmoid_f(1.5957691216f * (x + 0.044715f * x * x * x)); }
__device__ __forceinline__ float wave_sum(float v) {
#pragma unroll
    for (int o = 1; o < 64; o <<= 1) v += __shfl_xor(v, o);
    return v;
}

namespace pg8 {
constexpr int BM = 256, BK = 64, HALF = 128, HTB = HALF * BK * 2, STAGE_BYTES = 8 * HTB, NXCD = 8, WGM = 8;
__host__ __device__ __forceinline__ int lds_byte(int r, int c) { const int st = (r >> 4) * 2 + (c >> 5), rr = r & 15, cc = c & 31, ob = rr * 64 + cc * 2; return st * 1024 + (ob ^ (((ob >> 9) & 1) << 5)); }
__host__ __device__ __forceinline__ void stage_rc(int b, int& R, int& C) { const int st = b / 1024, sb = b % 1024, swz = sb ^ (((sb >> 9) & 1) << 5); R = (st >> 1) * 16 + swz / 64; C = (st & 1) * 32 + (swz % 64) / 2; }
__host__ __device__ __forceinline__ int perm32(int rho) { const int n = rho >> 4, i = rho & 15; return 8 * (i >> 2) + 4 * n + (i & 3); }

struct Unit { int pm, pn, z; };
struct Gemm { const bf16_t* A; const bf16_t* Bt; const bf16_t* A2; const bf16_t* Bt2; int M, N, K; };

struct StaticOrder {
    int nM, nN, nwg, G, c;
    __device__ void init(int M, int N, int G_, int c_) { nM = M / BM; nN = N / BM; nwg = nM * nN; G = G_; c = c_; }
    __device__ bool next(int i, Unit& u) const {
        const long L = (long)i * G + c; if (L >= nwg) return false;
        int wgid = (int)L; { const int q = nwg / NXCD, r = nwg % NXCD, xcd = wgid % NXCD, off = wgid / NXCD; wgid = (xcd < r ? xcd * (q + 1) : r * (q + 1) + (xcd - r) * q) + off; }
        const int nig = WGM * nN, gid = wgid / nig, fm = gid * WGM, gsz = (nM - fm) < WGM ? (nM - fm) : WGM;
        u.pm = fm + ((wgid % nig) % gsz); u.pn = (wgid % nig) / gsz; u.z = 0; return true;
    }
};
struct DualOrder {
    StaticOrder b;
    __device__ void init(int M, int N, int G_, int c_) { b.init(M, N, G_, c_); }
    __device__ bool next(int i, Unit& u) const { if (!b.next(i >> 1, u)) return false; u.z = i & 1; return true; }
};

template <class Epi, class Sched>
__device__ __forceinline__ void gemm_phase(LAS unsigned char* lds, const Gemm g, const Sched& S, const Epi& E) {
    int tid_ = threadIdx.x; asm volatile("" : "+v"(tid_));
    const int tid = tid_, wid = __builtin_amdgcn_readfirstlane(tid >> 6), lane = tid & 63, wr = wid >> 2, wc = wid & 3, fr = lane & 15, fq = lane >> 4;
    const int K = g.K, nt = K / BK;
    unsigned voffA[2], voffB[2];
#pragma unroll
    for (int i = 0; i < 2; ++i) { int R, C; stage_rc(tid * 16 + i * 8192, R, C); const int Rb = Epi::PERM ? ((R & ~31) + perm32(R & 31)) : R;
        voffA[i] = (unsigned)(R * K + C) * 2u; voffB[i] = (unsigned)(Rb * K + C) * 2u; }
    const size_t kstep = (size_t)(BK * 2);
    const size_t hstep = (size_t)HALF * K * 2;
    const size_t tstep = 2 * hstep;
    const unsigned ldsw = (unsigned)wid * 1024u;
    const int aoff = lds_byte(wr * 64 + fr, fq * 8), boff = lds_byte(wc * 32 + fr, fq * 8);
#define PG8_SA(b, h) (((b) * 2 + (h)) * HTB)
#define PG8_SB(b, h) ((4 + (b) * 2 + (h)) * HTB)
#define PG8_STAGE(bufoff, gbase, voff) do { _Pragma("unroll") for (int _i = 0; _i < 2; ++_i) \
        __builtin_amdgcn_global_load_lds((const unsigned*)((const char*)(gbase) + (voff)[_i]), (LAS unsigned*)(lds + (bufoff) + ldsw + _i * 8192), 16, 0, 0); } while (0)
#define PG8_LDA(dst, b, h) do { _Pragma("unroll") for (int m = 0; m < 4; ++m) _Pragma("unroll") for (int k = 0; k < 2; ++k) dst[m][k] = *(const LAS bf16x8*)(lds + PG8_SA(b, h) + aoff + m * 2048 + k * 1024); } while (0)
#define PG8_LDB(dst, b, h) do { _Pragma("unroll") for (int n = 0; n < 2; ++n) _Pragma("unroll") for (int k = 0; k < 2; ++k) dst[n][k] = *(const LAS bf16x8*)(lds + PG8_SB(b, h) + boff + n * 2048 + k * 1024); } while (0)
#define PG8_MMA(ai, bj, At, Bt) do { __builtin_amdgcn_s_setprio(1); _Pragma("unroll") for (int m = 0; m < 4; ++m) _Pragma("unroll") for (int n = 0; n < 2; ++n) _Pragma("unroll") for (int k = 0; k < 2; ++k) \
        acc[ai][bj][m][n] = __builtin_amdgcn_mfma_f32_16x16x32_bf16(Bt[n][k], At[m][k], acc[ai][bj][m][n], 0, 0, 0); __builtin_amdgcn_s_setprio(0); } while (0)
#define PG8_WAIT_V(n) asm volatile("s_waitcnt vmcnt(" #n ")" ::: "memory")
#define PG8_WAIT_L(n) asm volatile("s_waitcnt lgkmcnt(" #n ")" ::: "memory")
#define PG8_BAR __builtin_amdgcn_s_barrier()
#define PG8_SCHED __builtin_amdgcn_sched_barrier(0)
    Unit cur, nxt; int ui = 0;
    if (!S.next(0, cur)) return;
    f32x4 acc[2][2][4][2];
#pragma unroll
    for (int a = 0; a < 2; ++a)
#pragma unroll
        for (int b = 0; b < 2; ++b)
#pragma unroll
            for (int m = 0; m < 4; ++m)
#pragma unroll
                for (int n = 0; n < 2; ++n) acc[a][b][m][n] = (f32x4){0.f, 0.f, 0.f, 0.f};
    bf16x8 At[4][2], B0[2][2], B1[2][2];
    const char* cA = (const char*)(cur.z ? g.A2 : g.A) + (size_t)cur.pm * tstep; const char* cB = (const char*)(cur.z ? g.Bt2 : g.Bt) + (size_t)cur.pn * tstep;
    PG8_STAGE(PG8_SB(0, 0), cB, voffB); PG8_STAGE(PG8_SB(0, 1), cB + hstep, voffB); PG8_STAGE(PG8_SA(0, 0), cA, voffA); PG8_STAGE(PG8_SA(0, 1), cA + hstep, voffA);
    if (wr == 1) PG8_BAR;
    PG8_WAIT_V(2); PG8_BAR;
    PG8_STAGE(PG8_SB(1, 0), cB + kstep, voffB); PG8_STAGE(PG8_SA(1, 0), cA + kstep, voffA); PG8_STAGE(PG8_SB(1, 1), cB + hstep + kstep, voffB);
    PG8_WAIT_V(6); PG8_BAR;
    for (;;) {
        const bool has_next = S.next(ui + 1, nxt);
        const char* nA = has_next ? (const char*)(nxt.z ? g.A2 : g.A) + (size_t)nxt.pm * tstep : cA; const char* nB = has_next ? (const char*)(nxt.z ? g.Bt2 : g.Bt) + (size_t)nxt.pn * tstep : cB;
        for (int t = 0; t < nt; t += 2) {
            const bool last = (t == nt - 2);
            const char* a1 = cA + (size_t)(t + 1) * kstep;
            const char* a2 = last ? nA : cA + (size_t)(t + 2) * kstep; const char* b2 = last ? nB : cB + (size_t)(t + 2) * kstep;
            const char* a3 = a2 + kstep; const char* b3 = b2 + kstep;
            PG8_LDB(B0, 0, 0); PG8_LDB(B1, 0, 1); PG8_SCHED; PG8_LDA(At, 0, 0); PG8_STAGE(PG8_SA(1, 1), a1 + hstep, voffA);
            PG8_WAIT_V(8); PG8_WAIT_L(0); PG8_BAR; PG8_MMA(0, 0, At, B0); PG8_MMA(0, 1, At, B1); PG8_BAR; PG8_SCHED;
            PG8_LDA(At, 0, 1); PG8_STAGE(PG8_SB(0, 0), b2, voffB); PG8_STAGE(PG8_SB(0, 1), b2 + hstep, voffB); PG8_STAGE(PG8_SA(0, 0), a2, voffA);
            PG8_WAIT_V(8); PG8_WAIT_L(0); PG8_BAR; PG8_MMA(1, 0, At, B0); PG8_MMA(1, 1, At, B1); PG8_BAR; PG8_SCHED;
            PG8_LDB(B0, 1, 0); PG8_LDB(B1, 1, 1); PG8_SCHED; PG8_LDA(At, 1, 0); PG8_STAGE(PG8_SA(0, 1), a2 + hstep, voffA);
            PG8_WAIT_V(8); PG8_WAIT_L(0); PG8_BAR; PG8_MMA(0, 0, At, B0); PG8_MMA(0, 1, At, B1); PG8_BAR; PG8_SCHED;
            PG8_LDA(At, 1, 1); PG8_STAGE(PG8_SB(1, 0), b3, voffB); PG8_STAGE(PG8_SB(1, 1), b3 + hstep, voffB); PG8_STAGE(PG8_SA(1, 0), a3, voffA);
            PG8_WAIT_V(8); PG8_WAIT_L(0); PG8_BAR; PG8_MMA(1, 0, At, B0); PG8_MMA(1, 1, At, B1); PG8_BAR; PG8_SCHED;
        }
        if (wr == 0) PG8_BAR;
        E(acc, cur, wr, wc, fr, fq);
        if (!has_next) break;
#pragma unroll
        for (int a = 0; a < 2; ++a)
#pragma unroll
            for (int b = 0; b < 2; ++b)
#pragma unroll
                for (int m = 0; m < 4; ++m)
#pragma unroll
                    for (int n = 0; n < 2; ++n) acc[a][b][m][n] = (f32x4){0.f, 0.f, 0.f, 0.f};
        cur = nxt; cA = nA; cB = nB; ++ui;
        if (wr == 1) PG8_BAR;
    }
    PG8_WAIT_V(0);
    PG8_BAR;
#undef PG8_SA
#undef PG8_SB
#undef PG8_STAGE
#undef PG8_LDA
#undef PG8_LDB
#undef PG8_MMA
#undef PG8_WAIT_V
#undef PG8_WAIT_L
#undef PG8_BAR
#undef PG8_SCHED
}

struct EpiSwiGLU {
    static constexpr bool PERM = true;
    bf16_t* H;
    __device__ __forceinline__ void operator()(const f32x4 (&acc)[2][2][4][2], const Unit& u, int wr, int wc, int fr, int fq) const {
        const int row0 = u.pm * BM + wr * 64 + fr, col0 = u.pn * HALF + wc * 32 + 8 * fq;
#pragma unroll
        for (int ai = 0; ai < 2; ++ai)
#pragma unroll
            for (int m = 0; m < 4; ++m) {
                bf16_t* rowp = H + (size_t)(row0 + ai * HALF + m * 16) * FF + col0;
                const f32x4 g0 = acc[ai][0][m][0], g1 = acc[ai][0][m][1], u0 = acc[ai][1][m][0], u1 = acc[ai][1][m][1];
                u32x4 w;
                w.x = cvt_pk_bf16(silu_f(g0[0]) * u0[0], silu_f(g0[1]) * u0[1]); w.y = cvt_pk_bf16(silu_f(g0[2]) * u0[2], silu_f(g0[3]) * u0[3]);
                w.z = cvt_pk_bf16(silu_f(g1[0]) * u1[0], silu_f(g1[1]) * u1[1]); w.w = cvt_pk_bf16(silu_f(g1[2]) * u1[2], silu_f(g1[3]) * u1[3]);
                *(u32x4*)rowp = w;
            }
    }
};
struct EpiResid {
    static constexpr bool PERM = false;
    const float* res; float* out; float alpha, scale;
    __device__ __forceinline__ void operator()(const f32x4 (&acc)[2][2][4][2], const Unit& u, int wr, int wc, int fr, int fq) const {
        const int row0 = u.pm * BM + wr * 64 + fr, col0 = u.pn * BM + wc * 32 + 4 * fq;
#pragma unroll
        for (int ai = 0; ai < 2; ++ai)
#pragma unroll
            for (int m = 0; m < 4; ++m) {
                const size_t off = (size_t)(row0 + ai * HALF + m * 16) * DM + col0;
#pragma unroll
                for (int bj = 0; bj < 2; ++bj)
#pragma unroll
                    for (int n = 0; n < 2; ++n) { const f32x4 r = *(const f32x4*)(res + off + bj * HALF + n * 16); *(f32x4*)(out + off + bj * HALF + n * 16) = r * alpha + acc[ai][bj][m][n] * scale; }
                asm volatile("" ::: "memory");
            }
    }
};
struct EpiProj {
    static constexpr bool PERM = true;
    const float* bias; bf16_t *U, *V, *Z, *G;
    __device__ __forceinline__ void operator()(const f32x4 (&acc)[2][2][4][2], const Unit& u, int wr, int wc, int fr, int fq) const {
        const int row0 = u.pm * BM + wr * 64 + fr, cw = wc * 32 + 8 * fq;
        if (u.pn >= 8 && u.pn < 16) {
            const int jt = u.pn - 8;
            const f32x4 ba0 = *(const f32x4*)(bias + 2048 + 128 * jt + cw), ba1 = *(const f32x4*)(bias + 2048 + 128 * jt + cw + 4);
            const f32x4 bg0 = *(const f32x4*)(bias + 3072 + 128 * jt + cw), bg1 = *(const f32x4*)(bias + 3072 + 128 * jt + cw + 4);
#pragma unroll
            for (int ai = 0; ai < 2; ++ai)
#pragma unroll
                for (int m = 0; m < 4; ++m) {
                    bf16_t* rowp = Z + (size_t)(row0 + ai * HALF + m * 16) * AW + 128 * jt + cw;
                    const f32x4 a0 = acc[ai][0][m][0] + ba0, a1 = acc[ai][0][m][1] + ba1, g0 = acc[ai][1][m][0] + bg0, g1 = acc[ai][1][m][1] + bg1;
                    u32x4 w;
                    w.x = cvt_pk_bf16(a0[0] * sigmoid_f(g0[0]), a0[1] * sigmoid_f(g0[1])); w.y = cvt_pk_bf16(a0[2] * sigmoid_f(g0[2]), a0[3] * sigmoid_f(g0[3]));
                    w.z = cvt_pk_bf16(a1[0] * sigmoid_f(g1[0]), a1[1] * sigmoid_f(g1[1])); w.w = cvt_pk_bf16(a1[2] * sigmoid_f(g1[2]), a1[3] * sigmoid_f(g1[3]));
                    *(u32x4*)rowp = w;
                }
        } else {
            const bool is_gate = u.pn >= 16;
            bf16_t* base; int ldc, colt;
            if (is_gate) { base = G; ldc = 4096; colt = (u.pn - 16) * BM; } else if (u.pn < 4) { base = U; ldc = AW; colt = u.pn * BM; } else { base = V; ldc = AW; colt = (u.pn - 4) * BM; }
            f32x4 bv[2][2];
#pragma unroll
            for (int bj = 0; bj < 2; ++bj)
#pragma unroll
                for (int n = 0; n < 2; ++n) bv[bj][n] = *(const f32x4*)(bias + u.pn * BM + bj * HALF + cw + 4 * n);
#pragma unroll
            for (int ai = 0; ai < 2; ++ai)
#pragma unroll
                for (int m = 0; m < 4; ++m) {
                    bf16_t* rowp = base + (size_t)(row0 + ai * HALF + m * 16) * ldc + colt + cw;
#pragma unroll
                    for (int bj = 0; bj < 2; ++bj) {
                        const f32x4 v0 = acc[ai][bj][m][0] + bv[bj][0], v1 = acc[ai][bj][m][1] + bv[bj][1];
                        u32x4 w;
                        if (is_gate) {
                            w.x = cvt_pk_bf16(sigmoid_f(v0[0]), sigmoid_f(v0[1])); w.y = cvt_pk_bf16(sigmoid_f(v0[2]), sigmoid_f(v0[3]));
                            w.z = cvt_pk_bf16(sigmoid_f(v1[0]), sigmoid_f(v1[1])); w.w = cvt_pk_bf16(sigmoid_f(v1[2]), sigmoid_f(v1[3]));
                        } else {
                            w.x = cvt_pk_bf16(gelu_tanh_f(v0[0]), gelu_tanh_f(v0[1])); w.y = cvt_pk_bf16(gelu_tanh_f(v0[2]), gelu_tanh_f(v0[3]));
                            w.z = cvt_pk_bf16(gelu_tanh_f(v1[0]), gelu_tanh_f(v1[1])); w.w = cvt_pk_bf16(gelu_tanh_f(v1[2]), gelu_tanh_f(v1[3]));
                        }
                        *(u32x4*)(rowp + bj * HALF) = w;
                    }
                }
        }
    }
};
struct EpiMix {
    static constexpr bool PERM = true;
    const bf16_t* G; bf16_t* Mx; float* stash;
    __device__ __forceinline__ void operator()(const f32x4 (&acc)[2][2][4][2], const Unit& u, int wr, int wc, int fr, int fq) const {
        const int row0 = u.pm * BM + wr * 64 + fr, col0 = u.pn * BM + wc * 32 + 8 * fq;
        float* sp = stash + (size_t)threadIdx.x * 4;
        asm volatile("" : "+v"(sp));
        const bf16_t* gp = G + (size_t)row0 * 4096 + (u.z ? 2048 : 0) + col0;
        bf16_t* mp = Mx + (size_t)row0 * DM + col0;
        if (u.z == 0) {
#pragma unroll
            for (int ai = 0; ai < 2; ++ai)
#pragma unroll
                for (int m = 0; m < 4; ++m) {
#pragma unroll
                    for (int bj = 0; bj < 2; ++bj) {
                        const u32x4 gw = *(const u32x4*)(gp + (size_t)(ai * HALF + m * 16) * 4096 + bj * HALF);
                        const f32x4 ga = (f32x4){bf_lo(gw.x), bf_hi(gw.x), bf_lo(gw.y), bf_hi(gw.y)}, gb = (f32x4){bf_lo(gw.z), bf_hi(gw.z), bf_lo(gw.w), bf_hi(gw.w)};
                        *(f32x4*)sp = acc[ai][bj][m][0] * ga; *(f32x4*)(sp + 2048) = acc[ai][bj][m][1] * gb;
                        sp += 4096; asm volatile("" : "+v"(sp) :: "memory");
                    }
                }
        } else {
#pragma unroll
            for (int ai = 0; ai < 2; ++ai)
#pragma unroll
                for (int m = 0; m < 4; ++m) {
#pragma unroll
                    for (int bj = 0; bj < 2; ++bj) {
                        const u32x4 gw = *(const u32x4*)(gp + (size_t)(ai * HALF + m * 16) * 4096 + bj * HALF);
                        const f32x4 ga = (f32x4){bf_lo(gw.x), bf_hi(gw.x), bf_lo(gw.y), bf_hi(gw.y)}, gb = (f32x4){bf_lo(gw.z), bf_hi(gw.z), bf_lo(gw.w), bf_hi(gw.w)};
                        const f32x4 v0 = acc[ai][bj][m][0] * ga + *(const f32x4*)sp, v1 = acc[ai][bj][m][1] * gb + *(const f32x4*)(sp + 2048);
                        u32x4 w; w.x = cvt_pk_bf16(v0[0], v0[1]); w.y = cvt_pk_bf16(v0[2], v0[3]); w.z = cvt_pk_bf16(v1[0], v1[1]); w.w = cvt_pk_bf16(v1[2], v1[3]);
                        *(u32x4*)(mp + (size_t)(ai * HALF + m * 16) * DM + bj * HALF) = w;
                        sp += 4096; asm volatile("" : "+v"(sp) :: "memory");
                    }
                }
        }
    }
};
}

__device__ __forceinline__ void p0_transpose_item(const float* W, int K, int N, bf16_t* WT, int k0, int n0, int drow0, LAS float* scr, int lane) {
#pragma unroll 8
    for (int i = 0; i < 32; ++i) { const int kk = 2 * i + (lane >> 5); scr[kk * 33 + (lane & 31)] = W[(size_t)(k0 + kk) * N + n0 + (lane & 31)]; }
    asm volatile("s_waitcnt lgkmcnt(0)" ::: "memory");
    const int c = lane & 7;
#pragma unroll
    for (int j = 0; j < 4; ++j) { const int n = (lane >> 3) + 8 * j; const LAS float* s = scr + (8 * c) * 33 + n;
        u32x4 o; o.x = cvt_pk_bf16(s[0 * 33], s[1 * 33]); o.y = cvt_pk_bf16(s[2 * 33], s[3 * 33]); o.z = cvt_pk_bf16(s[4 * 33], s[5 * 33]); o.w = cvt_pk_bf16(s[6 * 33], s[7 * 33]);
        *(u32x4*)(WT + (size_t)(drow0 + n) * K + k0 + 8 * c) = o; }
    asm volatile("s_waitcnt lgkmcnt(0)" ::: "memory");
}
__device__ __forceinline__ int dest_row(int mode, int n0) {
    if (mode == 1) { const int half = n0 >= FF ? 1 : 0, j = n0 - half * FF; return 256 * (j >> 7) + 128 * half + (j & 127); }
    if (mode == 2) { if (n0 < 2048 || n0 >= 4096) return n0; const int half = n0 >= 3072 ? 1 : 0, j = n0 - 2048 - 1024 * half; return 2048 + 256 * (j >> 7) + 128 * half + (j & 127); }
    return n0;
}
__device__ __forceinline__ void p0_matrix(const float* W, int K, int N, bf16_t* WT, int mode, LAS float* scr, int gw, int NGW, int lane) {
    const int nblk = N / 32, nitems = (K / 64) * nblk;
    for (int it = gw; it < nitems; it += NGW) { const int kb = it / nblk, nb = it - kb * nblk; p0_transpose_item(W, K, N, WT, 64 * kb, 32 * nb, dest_row(mode, 32 * nb), scr, lane); }
}

__device__ __forceinline__ void ln_phase(const float* in, float* outf, bf16_t* outb, const float* g, const float* b, int gw, int NGW, int lane) {
    f32x4 gv[8], bv[8];
#pragma unroll
    for (int j = 0; j < 8; ++j) { gv[j] = ((const f32x4*)g)[lane + 64 * j]; bv[j] = ((const f32x4*)b)[lane + 64 * j]; }
    for (int m = gw; m < MTOK; m += NGW) {
        const f32x4* xr = (const f32x4*)(in + (size_t)m * DM) + lane;
        f32x4 v[8]; float s = 0.f;
#pragma unroll
        for (int j = 0; j < 8; ++j) { v[j] = xr[64 * j]; s += (v[j][0] + v[j][1]) + (v[j][2] + v[j][3]); }
        const float mean = wave_sum(s) * (1.f / DM); float s2 = 0.f;
#pragma unroll
        for (int j = 0; j < 8; ++j) { v[j] = v[j] - mean; s2 += (v[j][0] * v[j][0] + v[j][1] * v[j][1]) + (v[j][2] * v[j][2] + v[j][3] * v[j][3]); }
        const float rstd = 1.f / sqrtf(wave_sum(s2) * (1.f / DM) + LN_EPS);
        f32x4* of = (f32x4*)(outf + (size_t)m * DM) + lane;
#pragma unroll
        for (int j = 0; j < 8; ++j) { v[j] = v[j] * rstd * gv[j] + bv[j]; of[64 * j] = v[j]; }
        if (outb) {
            u32x2* ob = (u32x2*)(outb + (size_t)m * DM) + lane;
#pragma unroll
            for (int j = 0; j < 8; ++j) { u32x2 w; w.x = cvt_pk_bf16(v[j][0], v[j][1]); w.y = cvt_pk_bf16(v[j][2], v[j][3]); ob[64 * j] = w; }
        }
    }
}

__device__ __forceinline__ void sgu_item(LAS unsigned char* lds, const bf16_t* V, bf16_t* U, const bf16_t* Wsb, const float* bs, const float* lng, const float* lnb, int blk, int tid, int wave, int lane) {
    LAS float* st_mean = (LAS float*)lds; LAS float* st_rstd = st_mean + 128;
    LAS bf16_t* VnT = (LAS bf16_t*)(lds + 1024);
    const size_t t0 = (size_t)blk * 128;
#pragma unroll 4
    for (int rr = 0; rr < 16; ++rr) {
        const int row = wave * 16 + rr;
        const u32x4* vp = (const u32x4*)(V + (t0 + row) * AW) + lane;
        const u32x4 a = vp[0], b = vp[64];
        float s = ((bf_lo(a.x) + bf_hi(a.x)) + (bf_lo(a.y) + bf_hi(a.y))) + ((bf_lo(a.z) + bf_hi(a.z)) + (bf_lo(a.w) + bf_hi(a.w)))
                + ((bf_lo(b.x) + bf_hi(b.x)) + (bf_lo(b.y) + bf_hi(b.y))) + ((bf_lo(b.z) + bf_hi(b.z)) + (bf_lo(b.w) + bf_hi(b.w)));
        const float mean = wave_sum(s) * (1.f / AW);
        float q = 0.f;
#define SQ_(w) { const float d0 = bf_lo(w) - mean, d1 = bf_hi(w) - mean; q += d0 * d0 + d1 * d1; }
        SQ_(a.x) SQ_(a.y) SQ_(a.z) SQ_(a.w) SQ_(b.x) SQ_(b.y) SQ_(b.z) SQ_(b.w)
#undef SQ_
        const float rstd = 1.f / sqrtf(wave_sum(q) * (1.f / AW) + LN_EPS);
        if (lane == 0) { st_mean[row] = mean; st_rstd[row] = rstd; }
    }
    __syncthreads();
    const int j = tid & 127, chunk = wave >> 1;
    const float mj = st_mean[j], rj = st_rstd[j];
    const int r = lane & 15, q4 = lane >> 4;
    for (int h = 0; h < 8; ++h) {
        const int cb = h * 128 + chunk * 32;
        const u32x4* vp = (const u32x4*)(V + (t0 + j) * AW + cb);
        LAS bf16_t* dst = VnT + (chunk * 32) * 136 + j;
#pragma unroll
        for (int qd = 0; qd < 4; ++qd) {
            const u32x4 vv = vp[qd];
#pragma unroll
            for (int e = 0; e < 4; ++e) {
                const unsigned w = vv[e]; const int d = qd * 8 + e * 2;
                const float y0 = (bf_lo(w) - mj) * rj * lng[cb + d] + lnb[cb + d], y1 = (bf_hi(w) - mj) * rj * lng[cb + d + 1] + lnb[cb + d + 1];
                const unsigned pk = cvt_pk_bf16(y0, y1);
                dst[d * 136] = (bf16_t)(pk & 0xffffu); dst[(d + 1) * 136] = (bf16_t)(pk >> 16);
            }
        }
        __syncthreads();
        bf16x8 wf[4];
#pragma unroll
        for (int kk = 0; kk < 4; ++kk) wf[kk] = *(const bf16x8*)(Wsb + ((size_t)(h * 128 + wave * 16 + r) * 128 + kk * 32 + q4 * 8));
        const float bsi = bs[h * 128 + wave * 16 + r];
        bf16_t* urow = U + (t0 + wave * 16 + r) * AW + h * 128 + 4 * q4;
#pragma unroll
        for (int dt = 0; dt < 8; ++dt) {
            f32x4 acc = (f32x4){0.f, 0.f, 0.f, 0.f};
#pragma unroll
            for (int kk = 0; kk < 4; ++kk) { const bf16x8 vf = *(const LAS bf16x8*)(VnT + (dt * 16 + r) * 136 + kk * 32 + q4 * 8); acc = __builtin_amdgcn_mfma_f32_16x16x32_bf16(vf, wf[kk], acc, 0, 0, 0); }
            const u32x2 uu = *(const u32x2*)(urow + dt * 16);
            u32x2 o; o.x = cvt_pk_bf16(bf_lo(uu.x) * (acc[0] + bsi), bf_hi(uu.x) * (acc[1] + bsi)); o.y = cvt_pk_bf16(bf_lo(uu.y) * (acc[2] + bsi), bf_hi(uu.y) * (acc[3] + bsi));
            *(u32x2*)(urow + dt * 16) = o;
        }
        __syncthreads();
    }
}

__device__ __forceinline__ void conv_items(LAS unsigned char* lds, const bf16_t* Z, bf16_t* Bout, const float* wdw, const float* bdw, const float* lng, const float* lnb, int first, int stride, int tid, int wave, int lane) {
    LAS float* red = (LAS float*)lds;
    LAS float* tot = red + 256;
    const int c0 = 2 * tid;
    f32x2 w[31];
#pragma unroll
    for (int k = 0; k < 31; ++k) w[k] = *(const f32x2*)(wdw + k * AW + c0);
    const f32x2 bb = *(const f32x2*)(bdw + c0), gg = *(const f32x2*)(lng + c0), be = *(const f32x2*)(lnb + c0);
    for (int item = first; item < MTOK / 16; item += stride) {
        const size_t m0 = (size_t)item * 16; const int s0 = (int)(m0 & (SEQ - 1));
        f32x2 acc[16];
#pragma unroll
        for (int t = 0; t < 16; ++t) acc[t] = bb;
        const bf16_t* zp = Z + m0 * AW + c0;
#pragma unroll
        for (int idx = 0; idx < 46; ++idx) {
            unsigned zw = 0u;
            if (s0 + idx >= 30) zw = *(const unsigned*)(zp + (ptrdiff_t)(idx - 30) * AW);
            const f32x2 z = (f32x2){bf_lo(zw), bf_hi(zw)};
#pragma unroll
            for (int t = 0; t < 16; ++t) { if (idx - t >= 0 && idx - t <= 30) acc[t] += w[idx - t] * z; }
        }
#pragma unroll
        for (int t = 0; t < 16; ++t) {
            const float a = wave_sum(acc[t][0] + acc[t][1]), b = wave_sum(acc[t][0] * acc[t][0] + acc[t][1] * acc[t][1]);
            if (lane == 0) { red[wave * 32 + 2 * t] = a; red[wave * 32 + 2 * t + 1] = b; }
        }
        __syncthreads();
        if (tid < 32) { float s = 0.f;
#pragma unroll
            for (int wv = 0; wv < 8; ++wv) s += red[wv * 32 + tid];
            tot[tid] = s; }
        __syncthreads();
#pragma unroll
        for (int t = 0; t < 16; ++t) {
            const float mean = tot[2 * t] * (1.f / AW), var = tot[2 * t + 1] * (1.f / AW) - mean * mean, rstd = 1.f / sqrtf(var + LN_EPS);
            const f32x2 y = (acc[t] - mean) * rstd * gg + be;
            *(unsigned*)(Bout + (m0 + t) * AW + c0) = cvt_pk_bf16(silu_f(y[0]), silu_f(y[1]));
        }
        __syncthreads();
    }
}

#ifndef PHASE_MASK
#define PHASE_MASK 0xffffu
#endif
#define PH(n) (((PHASE_MASK) >> (n)) & 1u)
struct Params { const float* in[24]; float* out; unsigned char* ws; };

__global__ void __launch_bounds__(NTHREADS, 2) fwd_megakernel(Params p) {
    extern __shared__ __attribute__((aligned(16))) unsigned char lds_raw[];
    LAS unsigned char* lds = (LAS unsigned char*)lds_raw;
    cg::grid_group grid = cg::this_grid();
    const int tid = threadIdx.x, lane = tid & 63, wave = __builtin_amdgcn_readfirstlane(tid >> 6);
    const int G = gridDim.x, bx = blockIdx.x;
    const int gw = bx * NWAVES + wave, NGW = G * NWAVES;
    unsigned char* ws = p.ws;
    const float* x = p.in[0];
    float* out = p.out;
    bf16_t* Wgu1 = (bf16_t*)(ws + WS_WGU1); bf16_t* Wd1 = (bf16_t*)(ws + WS_WD1); bf16_t* Win = (bf16_t*)(ws + WS_WIN); bf16_t* Wa = (bf16_t*)(ws + WS_WA); bf16_t* Wb = (bf16_t*)(ws + WS_WB);
    bf16_t* Wout = (bf16_t*)(ws + WS_WOUT); bf16_t* Wgu2 = (bf16_t*)(ws + WS_WGU2); bf16_t* Wd2 = (bf16_t*)(ws + WS_WD2); bf16_t* Wsb = (bf16_t*)(ws + WS_WSB);
    bf16_t* XB = (bf16_t*)(ws + WS_XB); bf16_t* Hb = (bf16_t*)(ws + WS_H); bf16_t* Ub = (bf16_t*)(ws + WS_U); bf16_t* Vb = (bf16_t*)(ws + WS_V); bf16_t* Zb = (bf16_t*)(ws + WS_Z);
    bf16_t* Gb = (bf16_t*)(ws + WS_G); bf16_t* Bo = (bf16_t*)(ws + WS_BOUT);
    float* stash = (float*)(ws + WS_STASH) + (size_t)bx * 65536;

    if (PH(0)) {
        LAS float* scr = (LAS float*)(lds + wave * 16384);
        p0_matrix(p.in[1], DM, 2 * FF, Wgu1, 1, scr, gw, NGW, lane);
        p0_matrix(p.in[2], FF, DM, Wd1, 0, scr, gw, NGW, lane);
        p0_matrix(p.in[5], DM, INC, Win, 2, scr, gw, NGW, lane);
        p0_matrix(p.in[11], AW, DM, Wa, 0, scr, gw, NGW, lane);
        p0_matrix(p.in[16], AW, DM, Wb, 0, scr, gw, NGW, lane);
        p0_matrix(p.in[17], DM, DM, Wout, 0, scr, gw, NGW, lane);
        p0_matrix(p.in[20], DM, 2 * FF, Wgu2, 1, scr, gw, NGW, lane);
        p0_matrix(p.in[21], FF, DM, Wd2, 0, scr, gw, NGW, lane);
        const size_t gt = (size_t)bx * NTHREADS + tid, GT = (size_t)G * NTHREADS;
        for (size_t i = gt; i < (size_t)MTOK * DM / 8; i += GT) {
            const f32x4 a = ((const f32x4*)x)[2 * i], b = ((const f32x4*)x)[2 * i + 1];
            u32x4 w; w.x = cvt_pk_bf16(a[0], a[1]); w.y = cvt_pk_bf16(a[2], a[3]); w.z = cvt_pk_bf16(b[0], b[1]); w.w = cvt_pk_bf16(b[2], b[3]);
            ((u32x4*)XB)[i] = w;
        }
        const float* wsf = p.in[9];
        for (size_t i = gt; i < (size_t)8 * 128 * 128 / 2; i += GT) {
            const int jj = (int)((2 * i) & 127), ii = (int)(((2 * i) >> 7) & 127);
            const f32x2 v = ((const f32x2*)wsf)[i];
            const bool keep = !(ii < 64 && jj >= 64);
            ((unsigned*)Wsb)[i] = keep ? cvt_pk_bf16(v[0], v[1]) : 0u;
        }
    }
    grid.sync();
    if (PH(1)) { pg8::Gemm g{XB, Wgu1, nullptr, nullptr, MTOK, 2 * FF, DM}; pg8::StaticOrder S; S.init(MTOK, 2 * FF, G, bx); pg8::EpiSwiGLU E{Hb}; pg8::gemm_phase(lds, g, S, E); }
    grid.sync();
    if (PH(2)) { pg8::Gemm g{Hb, Wd1, nullptr, nullptr, MTOK, DM, FF}; pg8::StaticOrder S; S.init(MTOK, DM, G, bx); pg8::EpiResid E{x, out, ALPHA, 0.5f}; pg8::gemm_phase(lds, g, S, E); }
    grid.sync();
    if (PH(3)) ln_phase(out, out, XB, p.in[3], p.in[4], gw, NGW, lane);
    grid.sync();
    if (PH(4)) { pg8::Gemm g{XB, Win, nullptr, nullptr, MTOK, INC, DM}; pg8::StaticOrder S; S.init(MTOK, INC, G, bx); pg8::EpiProj E{p.in[6], Ub, Vb, Zb, Gb}; pg8::gemm_phase(lds, g, S, E); }
    grid.sync();
    if (PH(5)) for (int blk = bx; blk < MTOK / 128; blk += G) sgu_item(lds, Vb, Ub, Wsb, p.in[10], p.in[7], p.in[8], blk, tid, wave, lane);
    __syncthreads();
    if (PH(6)) conv_items(lds, Zb, Bo, p.in[12], p.in[13], p.in[14], p.in[15], bx, G, tid, wave, lane);
    grid.sync();
    if (PH(7)) { pg8::Gemm g{Ub, Wa, Bo, Wb, MTOK, DM, AW}; pg8::DualOrder S; S.init(MTOK, DM, G, bx); pg8::EpiMix E{Gb, XB, stash}; pg8::gemm_phase(lds, g, S, E); }
    grid.sync();
    if (PH(8)) { pg8::Gemm g{XB, Wout, nullptr, nullptr, MTOK, DM, DM}; pg8::StaticOrder S; S.init(MTOK, DM, G, bx); pg8::EpiResid E{out, out, ALPHA, 1.0f}; pg8::gemm_phase(lds, g, S, E); }
    grid.sync();
    if (PH(9)) ln_phase(out, out, XB, p.in[18], p.in[19], gw, NGW, lane);
    grid.sync();
    if (PH(10)) { pg8::Gemm g{XB, Wgu2, nullptr, nullptr, MTOK, 2 * FF, DM}; pg8::StaticOrder S; S.init(MTOK, 2 * FF, G, bx); pg8::EpiSwiGLU E{Hb}; pg8::gemm_phase(lds, g, S, E); }
    grid.sync();
    if (PH(11)) { pg8::Gemm g{Hb, Wd2, nullptr, nullptr, MTOK, DM, FF}; pg8::StaticOrder S; S.init(MTOK, DM, G, bx); pg8::EpiResid E{out, out, ALPHA, 0.5f}; pg8::gemm_phase(lds, g, S, E); }
    grid.sync();
    if (PH(12)) ln_phase(out, out, nullptr, p.in[22], p.in[23], gw, NGW, lane);
}

extern "C" void kernel_launch(void* const* d_in, const int* in_sizes, int n_in, void* d_out, int out_size, void* d_ws, size_t ws_size, hipStream_t stream) {
    static int grid_blocks = 0;
    if (grid_blocks == 0) {
        if (n_in != 24 || out_size != MTOK * DM || ws_size < WS_END) { fprintf(stderr, "kernel_launch: unexpected shapes: n_in %d out %d ws %zu\n", n_in, out_size, ws_size); grid_blocks = -1; return; }
        int dev = 0, cus = 0, per_cu = 0;
        (void)hipGetDevice(&dev);
        (void)hipDeviceGetAttribute(&cus, hipDeviceAttributeMultiprocessorCount, dev);
        if (hipFuncSetAttribute((const void*)fwd_megakernel, hipFuncAttributeMaxDynamicSharedMemorySize, LDS_BYTES) != hipSuccess) { fprintf(stderr, "kernel_launch: hipFuncSetAttribute failed\n"); grid_blocks = -1; return; }
        if (hipOccupancyMaxActiveBlocksPerMultiprocessor(&per_cu, (const void*)fwd_megakernel, NTHREADS, LDS_BYTES) != hipSuccess || per_cu < 1) { fprintf(stderr, "kernel_launch: occupancy query gave %d\n", per_cu); per_cu = 1; (void)hipGetLastError(); }
        grid_blocks = cus * per_cu;
    }
    if (grid_blocks < 0) return;
    Params p{};
    for (int i = 0; i < 24; ++i) p.in[i] = (const float*)d_in[i];
    p.out = (float*)d_out; p.ws = (unsigned char*)d_ws;
    void* args[] = {&p};
    hipError_t e = hipLaunchCooperativeKernel((const void*)fwd_megakernel, dim3(grid_blocks), dim3(NTHREADS), args, LDS_BYTES, stream);
    if (e != hipSuccess) fprintf(stderr, "kernel_launch: cooperative launch failed: %s (grid %d)\n", hipGetErrorString(e), grid_blocks);
}
```

```cpp
#include <hip/hip_runtime.h>
#include <hip/hip_cooperative_groups.h>
#include <cstdio>
#include <cstdint>
namespace cg = cooperative_groups;

#define LAS __attribute__((address_space(3)))
typedef unsigned short bf16_t;
typedef short bf16x8 __attribute__((ext_vector_type(8)));
typedef float f32x4 __attribute__((ext_vector_type(4)));
typedef float f32x2 __attribute__((ext_vector_type(2)));
typedef unsigned u32x4 __attribute__((ext_vector_type(4)));
typedef unsigned u32x2 __attribute__((ext_vector_type(2)));

constexpr int DM = 2048, MTOK = 4 * 8192, SEQ = 8192, FF = 5632, AW = 1024, INC = 8192;
constexpr float LN_EPS = 1e-5f, ALPHA = 1.189207115002721f;
constexpr int NWAVES = 8, NTHREADS = 512, LDS_BYTES = 147456;

constexpr size_t MiB = 1u << 20;
constexpr size_t WS_WGU1 = 0, WS_WD1 = 44 * MiB, WS_WIN = 66 * MiB, WS_WA = 98 * MiB, WS_WB = 102 * MiB, WS_WOUT = 106 * MiB, WS_WGU2 = 114 * MiB, WS_WD2 = 158 * MiB;
constexpr size_t WS_WSB = 180 * MiB, WS_CTL = 181 * MiB, CTL_BYTES = 16384, WS_STASH = 182 * MiB, WS_XB = 256 * MiB, WS_BIG = 384 * MiB, WS_BOUT = 832 * MiB, WS_END = 896 * MiB;
constexpr size_t WS_U = WS_BIG, WS_V = WS_BIG + 64 * MiB, WS_Z = WS_BIG + 128 * MiB, WS_G = WS_BIG + 192 * MiB, WS_H = WS_BIG;

__device__ __forceinline__ unsigned cvt_pk_bf16(float lo, float hi) { unsigned r; asm volatile("v_cvt_pk_bf16_f32 %0, %1, %2" : "=v"(r) : "v"(lo), "v"(hi)); return r; }
__device__ __forceinline__ float bf_lo(unsigned w) { return __uint_as_float(w << 16); }
__device__ __forceinline__ float bf_hi(unsigned w) { return __uint_as_float(w & 0xffff0000u); }
__device__ __forceinline__ float sigmoid_f(float y) { return __builtin_amdgcn_rcpf(1.0f + __builtin_amdgcn_exp2f(-1.4426950409f * y)); }
__device__ __forceinline__ float silu_f(float x) { return x * sigmoid_f(x); }
__device__ __forceinline__ float gelu_tanh_f(float x) { return x * sigmoid_f(1.5957691216f * (x + 0.044715f * x * x * x)); }
__device__ __forceinline__ float wave_sum(float v) {
#pragma unroll
    for (int o = 1; o < 64; o <<= 1) v += __shfl_xor(v, o);
    return v;
}

namespace pg8 {
constexpr int BM = 256, BK = 64, HALF = 128, HTB = HALF * BK * 2, STAGE_BYTES = 8 * HTB, NXCD = 8, WGM = 8;
__host__ __device__ __forceinline__ int lds_byte(int r, int c) { const int st = (r >> 4) * 2 + (c >> 5), rr = r & 15, cc = c & 31, ob = rr * 64 + cc * 2; return st * 1024 + (ob ^ (((ob >> 9) & 1) << 5)); }
__host__ __device__ __forceinline__ void stage_rc(int b, int& R, int& C) { const int st = b / 1024, sb = b % 1024, swz = sb ^ (((sb >> 9) & 1) << 5); R = (st >> 1) * 16 + swz / 64; C = (st & 1) * 32 + (swz % 64) / 2; }
__host__ __device__ __forceinline__ int perm32(int rho) { const int n = rho >> 4, i = rho & 15; return 8 * (i >> 2) + 4 * n + (i & 3); }

struct Unit { int pm, pn, z; };
struct Gemm { const bf16_t* A; const bf16_t* Bt; const bf16_t* A2; const bf16_t* Bt2; int M, N, K; };

struct StaticOrder {
    int nM, nN, nwg, G, c;
    __device__ void init(int M, int N, int G_, int c_) { nM = M / BM; nN = N / BM; nwg = nM * nN; G = G_; c = c_; }
    __device__ bool next(int i, Unit& u) const {
        const long L = (long)i * G + c; if (L >= nwg) return false;
        int wgid = (int)L; { const int q = nwg / NXCD, r = nwg % NXCD, xcd = wgid % NXCD, off = wgid / NXCD; wgid = (xcd < r ? xcd * (q + 1) : r * (q + 1) + (xcd - r) * q) + off; }
        const int nig = WGM * nN, gid = wgid / nig, fm = gid * WGM, gsz = (nM - fm) < WGM ? (nM - fm) : WGM;
        u.pm = fm + ((wgid % nig) % gsz); u.pn = (wgid % nig) / gsz; u.z = 0; return true;
    }
};
struct DualOrder {
    StaticOrder b;
    __device__ void init(int M, int N, int G_, int c_) { b.init(M, N, G_, c_); }
    __device__ bool next(int i, Unit& u) const { if (!b.next(i >> 1, u)) return false; u.z = i & 1; return true; }
};

template <class Epi, class Sched>
__device__ __forceinline__ void gemm_phase(LAS unsigned char* lds, const Gemm g, const Sched& S, const Epi& E) {
    int tid_ = threadIdx.x; asm volatile("" : "+v"(tid_));
    const int tid = tid_, wid = __builtin_amdgcn_readfirstlane(tid >> 6), lane = tid & 63, wr = wid >> 2, wc = wid & 3, fr = lane & 15, fq = lane >> 4;
    const int K = g.K, nt = K / BK;
    unsigned voffA[2], voffB[2];
#pragma unroll
    for (int i = 0; i < 2; ++i) { int R, C; stage_rc(tid * 16 + i * 8192, R, C); const int Rb = Epi::PERM ? ((R & ~31) + perm32(R & 31)) : R;
        voffA[i] = (unsigned)(R * K + C) * 2u; voffB[i] = (unsigned)(Rb * K + C) * 2u; }
    const size_t kstep = (size_t)(BK * 2);
    const size_t hstep = (size_t)HALF * K * 2;
    const size_t tstep = 2 * hstep;
    const unsigned ldsw = (unsigned)wid * 1024u;
    const int aoff = lds_byte(wr * 64 + fr, fq * 8), boff = lds_byte(wc * 32 + fr, fq * 8);
#define PG8_SA(b, h) (((b) * 2 + (h)) * HTB)
#define PG8_SB(b, h) ((4 + (b) * 2 + (h)) * HTB)
#define PG8_STAGE(bufoff, gbase, voff) do { _Pragma("unroll") for (int _i = 0; _i < 2; ++_i) \
        __builtin_amdgcn_global_load_lds((const unsigned*)((const char*)(gbase) + (voff)[_i]), (LAS unsigned*)(lds + (bufoff) + ldsw + _i * 8192), 16, 0, 0); } while (0)
#define PG8_LDA(dst, b, h) do { _Pragma("unroll") for (int m = 0; m < 4; ++m) _Pragma("unroll") for (int k = 0; k < 2; ++k) dst[m][k] = *(const LAS bf16x8*)(lds + PG8_SA(b, h) + aoff + m * 2048 + k * 1024); } while (0)
#define PG8_LDB(dst, b, h) do { _Pragma("unroll") for (int n = 0; n < 2; ++n) _Pragma("unroll") for (int k = 0; k < 2; ++k) dst[n][k] = *(const LAS bf16x8*)(lds + PG8_SB(b, h) + boff + n * 2048 + k * 1024); } while (0)
#define PG8_MMA(ai, bj, At, Bt) do { __builtin_amdgcn_s_setprio(1); _Pragma("unroll") for (int m = 0; m < 4; ++m) _Pragma("unroll") for (int n = 0; n < 2; ++n) _Pragma("unroll") for (int k = 0; k < 2; ++k) \
        acc[ai][bj][m][n] = __builtin_amdgcn_mfma_f32_16x16x32_bf16(Bt[n][k], At[m][k], acc[ai][bj][m][n], 0, 0, 0); __builtin_amdgcn_s_setprio(0); } while (0)
#define PG8_WAIT_V(n) asm volatile("s_waitcnt vmcnt(" #n ")" ::: "memory")
#define PG8_WAIT_L(n) asm volatile("s_waitcnt lgkmcnt(" #n ")" ::: "memory")
#define PG8_BAR __builtin_amdgcn_s_barrier()
#define PG8_SCHED __builtin_amdgcn_sched_barrier(0)
    Unit cur, nxt; int ui = 0;
    if (!S.next(0, cur)) return;
    f32x4 acc[2][2][4][2];
#pragma unroll
    for (int a = 0; a < 2; ++a)
#pragma unroll
        for (int b = 0; b < 2; ++b)
#pragma unroll
            for (int m = 0; m < 4; ++m)
#pragma unroll
                for (int n = 0; n < 2; ++n) acc[a][b][m][n] = (f32x4){0.f, 0.f, 0.f, 0.f};
    bf16x8 At[4][2], B0[2][2], B1[2][2];
    const char* cA = (const char*)(cur.z ? g.A2 : g.A) + (size_t)cur.pm * tstep; const char* cB = (const char*)(cur.z ? g.Bt2 : g.Bt) + (size_t)cur.pn * tstep;
    PG8_STAGE(PG8_SB(0, 0), cB, voffB); PG8_STAGE(PG8_SB(0, 1), cB + hstep, voffB); PG8_STAGE(PG8_SA(0, 0), cA, voffA); PG8_STAGE(PG8_SA(0, 1), cA + hstep, voffA);
    if (wr == 1) PG8_BAR;
    PG8_WAIT_V(2); PG8_BAR;
    PG8_STAGE(PG8_SB(1, 0), cB + kstep, voffB); PG8_STAGE(PG8_SA(1, 0), cA + kstep, voffA); PG8_STAGE(PG8_SB(1, 1), cB + hstep + kstep, voffB);
    PG8_WAIT_V(6); PG8_BAR;
    for (;;) {
        const bool has_next = S.next(ui + 1, nxt);
        const char* nA = has_next ? (const char*)(nxt.z ? g.A2 : g.A) + (size_t)nxt.pm * tstep : cA; const char* nB = has_next ? (const char*)(nxt.z ? g.Bt2 : g.Bt) + (size_t)nxt.pn * tstep : cB;
        for (int t = 0; t < nt; t += 2) {
            const bool last = (t == nt - 2);
            const char* a1 = cA + (size_t)(t + 1) * kstep;
            const char* a2 = last ? nA : cA + (size_t)(t + 2) * kstep; const char* b2 = last ? nB : cB + (size_t)(t + 2) * kstep;
            const char* a3 = a2 + kstep; const char* b3 = b2 + kstep;
            PG8_LDB(B0, 0, 0); PG8_LDB(B1, 0, 1); PG8_SCHED; PG8_LDA(At, 0, 0); PG8_STAGE(PG8_SA(1, 1), a1 + hstep, voffA);
            PG8_WAIT_V(8); PG8_WAIT_L(0); PG8_BAR; PG8_MMA(0, 0, At, B0); PG8_MMA(0, 1, At, B1); PG8_BAR; PG8_SCHED;
            PG8_LDA(At, 0, 1); PG8_STAGE(PG8_SB(0, 0), b2, voffB); PG8_STAGE(PG8_SB(0, 1), b2 + hstep, voffB); PG8_STAGE(PG8_SA(0, 0), a2, voffA);
            PG8_WAIT_V(8); PG8_WAIT_L(0); PG8_BAR; PG8_MMA(1, 0, At, B0); PG8_MMA(1, 1, At, B1); PG8_BAR; PG8_SCHED;
            PG8_LDB(B0, 1, 0); PG8_LDB(B1, 1, 1); PG8_SCHED; PG8_LDA(At, 1, 0); PG8_STAGE(PG8_SA(0, 1), a2 + hstep, voffA);
            PG8_WAIT_V(8); PG8_WAIT_L(0); PG8_BAR; PG8_MMA(0, 0, At, B0); PG8_MMA(0, 1, At, B1); PG8_BAR; PG8_SCHED;
            PG8_LDA(At, 1, 1); PG8_STAGE(PG8_SB(1, 0), b3, voffB); PG8_STAGE(PG8_SB(1, 1), b3 + hstep, voffB); PG8_STAGE(PG8_SA(1, 0), a3, voffA);
            PG8_WAIT_V(8); PG8_WAIT_L(0); PG8_BAR; PG8_MMA(1, 0, At, B0); PG8_MMA(1, 1, At, B1); PG8_BAR; PG8_SCHED;
        }
        if (wr == 0) PG8_BAR;
        E(acc, cur, wr, wc, fr, fq);
        if (!has_next) break;
#pragma unroll
        for (int a = 0; a < 2; ++a)
#pragma unroll
            for (int b = 0; b < 2; ++b)
#pragma unroll
                for (int m = 0; m < 4; ++m)
#pragma unroll
                    for (int n = 0; n < 2; ++n) acc[a][b][m][n] = (f32x4){0.f, 0.f, 0.f, 0.f};
        cur = nxt; cA = nA; cB = nB; ++ui;
        if (wr == 1) PG8_BAR;
    }
    PG8_WAIT_V(0);
    PG8_BAR;
#undef PG8_SA
#undef PG8_SB
#undef PG8_STAGE
#undef PG8_LDA
#undef PG8_LDB
#undef PG8_MMA
#undef PG8_WAIT_V
#undef PG8_WAIT_L
#undef PG8_BAR
#undef PG8_SCHED
}

struct EpiSwiGLU {
    static constexpr bool PERM = true;
    bf16_t* H;
    __device__ __forceinline__ void operator()(const f32x4 (&acc)[2][2][4][2], const Unit& u, int wr, int wc, int fr, int fq) const {
        const int row0 = u.pm * BM + wr * 64 + fr, col0 = u.pn * HALF + wc * 32 + 8 * fq;
#pragma unroll
        for (int ai = 0; ai < 2; ++ai)
#pragma unroll
            for (int m = 0; m < 4; ++m) {
                bf16_t* rowp = H + (size_t)(row0 + ai * HALF + m * 16) * FF + col0;
                const f32x4 g0 = acc[ai][0][m][0], g1 = acc[ai][0][m][1], u0 = acc[ai][1][m][0], u1 = acc[ai][1][m][1];
                u32x4 w;
                w.x = cvt_pk_bf16(silu_f(g0[0]) * u0[0], silu_f(g0[1]) * u0[1]); w.y = cvt_pk_bf16(silu_f(g0[2]) * u0[2], silu_f(g0[3]) * u0[3]);
                w.z = cvt_pk_bf16(silu_f(g1[0]) * u1[0], silu_f(g1[1]) * u1[1]); w.w = cvt_pk_bf16(silu_f(g1[2]) * u1[2], silu_f(g1[3]) * u1[3]);
                *(u32x4*)rowp = w;
            }
    }
};
struct EpiResid {
    static constexpr bool PERM = false;
    const float* res; float* out; float alpha, scale;
    __device__ __forceinline__ void operator()(const f32x4 (&acc)[2][2][4][2], const Unit& u, int wr, int wc, int fr, int fq) const {
        const int row0 = u.pm * BM + wr * 64 + fr, col0 = u.pn * BM + wc * 32 + 4 * fq;
#pragma unroll
        for (int ai = 0; ai < 2; ++ai)
#pragma unroll
            for (int m = 0; m < 4; ++m) {
                const size_t off = (size_t)(row0 + ai * HALF + m * 16) * DM + col0;
#pragma unroll
                for (int bj = 0; bj < 2; ++bj)
#pragma unroll
                    for (int n = 0; n < 2; ++n) { const f32x4 r = *(const f32x4*)(res + off + bj * HALF + n * 16); *(f32x4*)(out + off + bj * HALF + n * 16) = r * alpha + acc[ai][bj][m][n] * scale; }
                asm volatile("" ::: "memory");
            }
    }
};
struct EpiProj {
    static constexpr bool PERM = true;
    const float* bias; bf16_t *U, *V, *Z, *G;
    __device__ __forceinline__ void operator()(const f32x4 (&acc)[2][2][4][2], const Unit& u, int wr, int wc, int fr, int fq) const {
        const int row0 = u.pm * BM + wr * 64 + fr, cw = wc * 32 + 8 * fq;
        if (u.pn >= 8 && u.pn < 16) {
            const int jt = u.pn - 8;
            const f32x4 ba0 = *(const f32x4*)(bias + 2048 + 128 * jt + cw), ba1 = *(const f32x4*)(bias + 2048 + 128 * jt + cw + 4);
            const f32x4 bg0 = *(const f32x4*)(bias + 3072 + 128 * jt + cw), bg1 = *(const f32x4*)(bias + 3072 + 128 * jt + cw + 4);
#pragma unroll
            for (int ai = 0; ai < 2; ++ai)
#pragma unroll
                for (int m = 0; m < 4; ++m) {
                    bf16_t* rowp = Z + (size_t)(row0 + ai * HALF + m * 16) * AW + 128 * jt + cw;
                    const f32x4 a0 = acc[ai][0][m][0] + ba0, a1 = acc[ai][0][m][1] + ba1, g0 = acc[ai][1][m][0] + bg0, g1 = acc[ai][1][m][1] + bg1;
                    u32x4 w;
                    w.x = cvt_pk_bf16(a0[0] * sigmoid_f(g0[0]), a0[1] * sigmoid_f(g0[1])); w.y = cvt_pk_bf16(a0[2] * sigmoid_f(g0[2]), a0[3] * sigmoid_f(g0[3]));
                    w.z = cvt_pk_bf16(a1[0] * sigmoid_f(g1[0]), a1[1] * sigmoid_f(g1[1])); w.w = cvt_pk_bf16(a1[2] * sigmoid_f(g1[2]), a1[3] * sigmoid_f(g1[3]));
                    *(u32x4*)rowp = w;
                }
        } else {
            const bool is_gate = u.pn >= 16;
            bf16_t* base; int ldc, colt;
            if (is_gate) { base = G; ldc = 4096; colt = (u.pn - 16) * BM; } else if (u.pn < 4) { base = U; ldc = AW; colt = u.pn * BM; } else { base = V; ldc = AW; colt = (u.pn - 4) * BM; }
            f32x4 bv[2][2];
#pragma unroll
            for (int bj = 0; bj < 2; ++bj)
#pragma unroll
                for (int n = 0; n < 2; ++n) bv[bj][n] = *(const f32x4*)(bias + u.pn * BM + bj * HALF + cw + 4 * n);
#pragma unroll
            for (int ai = 0; ai < 2; ++ai)
#pragma unroll
                for (int m = 0; m < 4; ++m) {
                    bf16_t* rowp = base + (size_t)(row0 + ai * HALF + m * 16) * ldc + colt + cw;
#pragma unroll
                    for (int bj = 0; bj < 2; ++bj) {
                        const f32x4 v0 = acc[ai][bj][m][0] + bv[bj][0], v1 = acc[ai][bj][m][1] + bv[bj][1];
                        u32x4 w;
                        if (is_gate) {
                            w.x = cvt_pk_bf16(sigmoid_f(v0[0]), sigmoid_f(v0[1])); w.y = cvt_pk_bf16(sigmoid_f(v0[2]), sigmoid_f(v0[3]));
                            w.z = cvt_pk_bf16(sigmoid_f(v1[0]), sigmoid_f(v1[1])); w.w = cvt_pk_bf16(sigmoid_f(v1[2]), sigmoid_f(v1[3]));
                        } else {
                            w.x = cvt_pk_bf16(gelu_tanh_f(v0[0]), gelu_tanh_f(v0[1])); w.y = cvt_pk_bf16(gelu_tanh_f(v0[2]), gelu_tanh_f(v0[3]));
                            w.z = cvt_pk_bf16(gelu_tanh_f(v1[0]), gelu_tanh_f(v1[1])); w.w = cvt_pk_bf16(gelu_tanh_f(v1[2]), gelu_tanh_f(v1[3]));
                        }
                        *(u32x4*)(rowp + bj * HALF) = w;
                    }
                }
        }
    }
};
struct EpiMix {
    static constexpr bool PERM = true;
    const bf16_t* G; bf16_t* Mx; float* stash;
    __device__ __forceinline__ void operator()(const f32x4 (&acc)[2][2][4][2], const Unit& u, int wr, int wc, int fr, int fq) const {
        const int row0 = u.pm * BM + wr * 64 + fr, col0 = u.pn * BM + wc * 32 + 8 * fq;
        float* sp = stash + (size_t)threadIdx.x * 4;
        asm volatile("" : "+v"(sp));
        const bf16_t* gp = G + (size_t)row0 * 4096 + (u.z ? 2048 : 0) + col0;
        bf16_t* mp = Mx + (size_t)row0 * DM + col0;
        if (u.z == 0) {
#pragma unroll
            for (int ai = 0; ai < 2; ++ai)
#pragma unroll
                for (int m = 0; m < 4; ++m) {
#pragma unroll
                    for (int bj = 0; bj < 2; ++bj) {
                        const u32x4 gw = *(const u32x4*)(gp + (size_t)(ai * HALF + m * 16) * 4096 + bj * HALF);
                        const f32x4 ga = (f32x4){bf_lo(gw.x), bf_hi(gw.x), bf_lo(gw.y), bf_hi(gw.y)}, gb = (f32x4){bf_lo(gw.z), bf_hi(gw.z), bf_lo(gw.w), bf_hi(gw.w)};
                        *(f32x4*)sp = acc[ai][bj][m][0] * ga; *(f32x4*)(sp + 2048) = acc[ai][bj][m][1] * gb;
                        sp += 4096; asm volatile("" : "+v"(sp) :: "memory");
                    }
                }
        } else {
#pragma unroll
            for (int ai = 0; ai < 2; ++ai)
#pragma unroll
                for (int m = 0; m < 4; ++m) {
#pragma unroll
                    for (int bj = 0; bj < 2; ++bj) {
                        const u32x4 gw = *(const u32x4*)(gp + (size_t)(ai * HALF + m * 16) * 4096 + bj * HALF);
                        const f32x4 ga = (f32x4){bf_lo(gw.x), bf_hi(gw.x), bf_lo(gw.y), bf_hi(gw.y)}, gb = (f32x4){bf_lo(gw.z), bf_hi(gw.z), bf_lo(gw.w), bf_hi(gw.w)};
                        const f32x4 v0 = acc[ai][bj][m][0] * ga + *(const f32x4*)sp, v1 = acc[ai][bj][m][1] * gb + *(const f32x4*)(sp + 2048);
                        u32x4 w; w.x = cvt_pk_bf16(v0[0], v0[1]); w.y = cvt_pk_bf16(v0[2], v0[3]); w.z = cvt_pk_bf16(v1[0], v1[1]); w.w = cvt_pk_bf16(v1[2], v1[3]);
                        *(u32x4*)(mp + (size_t)(ai * HALF + m * 16) * DM + bj * HALF) = w;
                        sp += 4096; asm volatile("" : "+v"(sp) :: "memory");
                    }
                }
        }
    }
};
}

__device__ __forceinline__ void p0_transpose_item(const float* W, int K, int N, bf16_t* WT, int k0, int n0, int drow0, LAS float* scr, int lane) {
#pragma unroll 8
    for (int i = 0; i < 32; ++i) { const int kk = 2 * i + (lane >> 5); scr[kk * 33 + (lane & 31)] = W[(size_t)(k0 + kk) * N + n0 + (lane & 31)]; }
    asm volatile("s_waitcnt lgkmcnt(0)" ::: "memory");
    const int c = lane & 7;
#pragma unroll
    for (int j = 0; j < 4; ++j) { const int n = (lane >> 3) + 8 * j; const LAS float* s = scr + (8 * c) * 33 + n;
        u32x4 o; o.x = cvt_pk_bf16(s[0 * 33], s[1 * 33]); o.y = cvt_pk_bf16(s[2 * 33], s[3 * 33]); o.z = cvt_pk_bf16(s[4 * 33], s[5 * 33]); o.w = cvt_pk_bf16(s[6 * 33], s[7 * 33]);
        *(u32x4*)(WT + (size_t)(drow0 + n) * K + k0 + 8 * c) = o; }
    asm volatile("s_waitcnt lgkmcnt(0)" ::: "memory");
}
__device__ __forceinline__ int dest_row(int mode, int n0) {
    if (mode == 1) { const int half = n0 >= FF ? 1 : 0, j = n0 - half * FF; return 256 * (j >> 7) + 128 * half + (j & 127); }
    if (mode == 2) { if (n0 < 2048 || n0 >= 4096) return n0; const int half = n0 >= 3072 ? 1 : 0, j = n0 - 2048 - 1024 * half; return 2048 + 256 * (j >> 7) + 128 * half + (j & 127); }
    return n0;
}
__device__ __forceinline__ void p0_matrix(const float* W, int K, int N, bf16_t* WT, int mode, LAS float* scr, int gw, int NGW, int lane) {
    const int nblk = N / 32, nitems = (K / 64) * nblk;
    for (int it = gw; it < nitems; it += NGW) { const int kb = it / nblk, nb = it - kb * nblk; p0_transpose_item(W, K, N, WT, 64 * kb, 32 * nb, dest_row(mode, 32 * nb), scr, lane); }
}

__device__ __forceinline__ void ln_phase(const float* in, float* outf, bf16_t* outb, const float* g, const float* b, int gw, int NGW, int lane) {
    f32x4 gv[8], bv[8];
#pragma unroll
    for (int j = 0; j < 8; ++j) { gv[j] = ((const f32x4*)g)[lane + 64 * j]; bv[j] = ((const f32x4*)b)[lane + 64 * j]; }
    for (int m = gw; m < MTOK; m += NGW) {
        const f32x4* xr = (const f32x4*)(in + (size_t)m * DM) + lane;
        f32x4 v[8]; float s = 0.f;
#pragma unroll
        for (int j = 0; j < 8; ++j) { v[j] = xr[64 * j]; s += (v[j][0] + v[j][1]) + (v[j][2] + v[j][3]); }
        const float mean = wave_sum(s) * (1.f / DM); float s2 = 0.f;
#pragma unroll
        for (int j = 0; j < 8; ++j) { v[j] = v[j] - mean; s2 += (v[j][0] * v[j][0] + v[j][1] * v[j][1]) + (v[j][2] * v[j][2] + v[j][3] * v[j][3]); }
        const float rstd = 1.f / sqrtf(wave_sum(s2) * (1.f / DM) + LN_EPS);
        f32x4* of = (f32x4*)(outf + (size_t)m * DM) + lane;
#pragma unroll
        for (int j = 0; j < 8; ++j) { v[j] = v[j] * rstd * gv[j] + bv[j]; of[64 * j] = v[j]; }
        if (outb) {
            u32x2* ob = (u32x2*)(outb + (size_t)m * DM) + lane;
#pragma unroll
            for (int j = 0; j < 8; ++j) { u32x2 w; w.x = cvt_pk_bf16(v[j][0], v[j][1]); w.y = cvt_pk_bf16(v[j][2], v[j][3]); ob[64 * j] = w; }
        }
    }
}

__device__ __forceinline__ void sgu_item(LAS unsigned char* lds, const bf16_t* V, bf16_t* U, const bf16_t* Wsb, const float* bs, const float* lng, const float* lnb, int blk, int tid, int wave, int lane) {
    LAS float* st_mean = (LAS float*)lds; LAS float* st_rstd = st_mean + 128;
    LAS bf16_t* VnT = (LAS bf16_t*)(lds + 1024);
    const size_t t0 = (size_t)blk * 128;
#pragma unroll 4
    for (int rr = 0; rr < 16; ++rr) {
        const int row = wave * 16 + rr;
        const u32x4* vp = (const u32x4*)(V + (t0 + row) * AW) + lane;
        const u32x4 a = vp[0], b = vp[64];
        float s = ((bf_lo(a.x) + bf_hi(a.x)) + (bf_lo(a.y) + bf_hi(a.y))) + ((bf_lo(a.z) + bf_hi(a.z)) + (bf_lo(a.w) + bf_hi(a.w)))
                + ((bf_lo(b.x) + bf_hi(b.x)) + (bf_lo(b.y) + bf_hi(b.y))) + ((bf_lo(b.z) + bf_hi(b.z)) + (bf_lo(b.w) + bf_hi(b.w)));
        const float mean = wave_sum(s) * (1.f / AW);
        float q = 0.f;
#define SQ_(w) { const float d0 = bf_lo(w) - mean, d1 = bf_hi(w) - mean; q += d0 * d0 + d1 * d1; }
        SQ_(a.x) SQ_(a.y) SQ_(a.z) SQ_(a.w) SQ_(b.x) SQ_(b.y) SQ_(b.z) SQ_(b.w)
#undef SQ_
        const float rstd = 1.f / sqrtf(wave_sum(q) * (1.f / AW) + LN_EPS);
        if (lane == 0) { st_mean[row] = mean; st_rstd[row] = rstd; }
    }
    __syncthreads();
    const int j = tid & 127, chunk = wave >> 1;
    const float mj = st_mean[j], rj = st_rstd[j];
    const int r = lane & 15, q4 = lane >> 4;
    for (int h = 0; h < 8; ++h) {
        const int cb = h * 128 + chunk * 32;
        const u32x4* vp = (const u32x4*)(V + (t0 + j) * AW + cb);
        LAS bf16_t* dst = VnT + (chunk * 32) * 136 + j;
#pragma unroll
        for (int qd = 0; qd < 4; ++qd) {
            const u32x4 vv = vp[qd];
#pragma unroll
            for (int e = 0; e < 4; ++e) {
                const unsigned w = vv[e]; const int d = qd * 8 + e * 2;
                const float y0 = (bf_lo(w) - mj) * rj * lng[cb + d] + lnb[cb + d], y1 = (bf_hi(w) - mj) * rj * lng[cb + d + 1] + lnb[cb + d + 1];
                const unsigned pk = cvt_pk_bf16(y0, y1);
                dst[d * 136] = (bf16_t)(pk & 0xffffu); dst[(d + 1) * 136] = (bf16_t)(pk >> 16);
            }
        }
        __syncthreads();
        bf16x8 wf[4];
#pragma unroll
        for (int kk = 0; kk < 4; ++kk) wf[kk] = *(const bf16x8*)(Wsb + ((size_t)(h * 128 + wave * 16 + r) * 128 + kk * 32 + q4 * 8));
        const float bsi = bs[h * 128 + wave * 16 + r];
        bf16_t* urow = U + (t0 + wave * 16 + r) * AW + h * 128 + 4 * q4;
#pragma unroll
        for (int dt = 0; dt < 8; ++dt) {
            f32x4 acc = (f32x4){0.f, 0.f, 0.f, 0.f};
#pragma unroll
            for (int kk = 0; kk < 4; ++kk) { const bf16x8 vf = *(const LAS bf16x8*)(VnT + (dt * 16 + r) * 136 + kk * 32 + q4 * 8); acc = __builtin_amdgcn_mfma_f32_16x16x32_bf16(vf, wf[kk], acc, 0, 0, 0); }
            const u32x2 uu = *(const u32x2*)(urow + dt * 16);
            u32x2 o; o.x = cvt_pk_bf16(bf_lo(uu.x) * (acc[0] + bsi), bf_hi(uu.x) * (acc[1] + bsi)); o.y = cvt_pk_bf16(bf_lo(uu.y) * (acc[2] + bsi), bf_hi(uu.y) * (acc[3] + bsi));
            *(u32x2*)(urow + dt * 16) = o;
        }
        __syncthreads();
    }
}

__device__ __forceinline__ void conv_items(LAS unsigned char* lds, const bf16_t* Z, bf16_t* Bout, const float* wdw, const float* bdw, const float* lng, const float* lnb, int first, int stride, int tid, int wave, int lane) {
    LAS float* red = (LAS float*)lds;
    LAS float* tot = red + 256;
    const int c0 = 2 * tid;
    f32x2 w[31];
#pragma unroll
    for (int k = 0; k < 31; ++k) w[k] = *(const f32x2*)(wdw + k * AW + c0);
    const f32x2 bb = *(const f32x2*)(bdw + c0), gg = *(const f32x2*)(lng + c0), be = *(const f32x2*)(lnb + c0);
    for (int item = first; item < MTOK / 16; item += stride) {
        const size_t m0 = (size_t)item * 16; const int s0 = (int)(m0 & (SEQ - 1));
        f32x2 acc[16];
#pragma unroll
        for (int t = 0; t < 16; ++t) acc[t] = bb;
        const bf16_t* zp = Z + m0 * AW + c0;
#pragma unroll
        for (int idx = 0; idx < 46; ++idx) {
            unsigned zw = 0u;
            if (s0 + idx >= 30) zw = *(const unsigned*)(zp + (ptrdiff_t)(idx - 30) * AW);
            const f32x2 z = (f32x2){bf_lo(zw), bf_hi(zw)};
#pragma unroll
            for (int t = 0; t < 16; ++t) { if (idx - t >= 0 && idx - t <= 30) acc[t] += w[idx - t] * z; }
        }
#pragma unroll
        for (int t = 0; t < 16; ++t) {
            const float a = wave_sum(acc[t][0] + acc[t][1]), b = wave_sum(acc[t][0] * acc[t][0] + acc[t][1] * acc[t][1]);
            if (lane == 0) { red[wave * 32 + 2 * t] = a; red[wave * 32 + 2 * t + 1] = b; }
        }
        __syncthreads();
        if (tid < 32) { float s = 0.f;
#pragma unroll
            for (int wv = 0; wv < 8; ++wv) s += red[wv * 32 + tid];
            tot[tid] = s; }
        __syncthreads();
#pragma unroll
        for (int t = 0; t < 16; ++t) {
            const float mean = tot[2 * t] * (1.f / AW), var = tot[2 * t + 1] * (1.f / AW) - mean * mean, rstd = 1.f / sqrtf(var + LN_EPS);
            const f32x2 y = (acc[t] - mean) * rstd * gg + be;
            *(unsigned*)(Bout + (m0 + t) * AW + c0) = cvt_pk_bf16(silu_f(y[0]), silu_f(y[1]));
        }
        __syncthreads();
    }
}


#define XB_TMO      128
#define XB_XCNT(j)  (256  + 64 * (j))
#define XB_XSUB(j)  (1280 + 64 * (j))
#define XB_XGEN(j)  (2304 + 64 * (j))
#define XB_TOP      3328
#define XB_TOPGEN   3392
#define XCD_BAR_WORDS 3456
#define XB_SPIN_CAP (1u << 22)
__device__ __forceinline__ unsigned xb_ld(unsigned* p)              { return __hip_atomic_load(p, __ATOMIC_RELAXED, __HIP_MEMORY_SCOPE_AGENT); }
__device__ __forceinline__ unsigned xb_add(unsigned* p, unsigned v) { return __hip_atomic_fetch_add(p, v, __ATOMIC_RELAXED, __HIP_MEMORY_SCOPE_AGENT); }
__device__ __forceinline__ unsigned xb_xcc_id() { return (unsigned)__builtin_amdgcn_s_getreg((3 << 11) | 20) & 0xFu; }
#define XB_SPIN(cond, bar) do { unsigned _sp = 0; while (cond) { __builtin_amdgcn_s_sleep(1); \
    if ((++_sp & 255u) == 0u) { if (xb_ld(&(bar)[XB_TMO])) break; if (_sp > XB_SPIN_CAP) { atomicAdd(&(bar)[XB_TMO], 1u); break; } } } } while (0)
struct XcdBarrier { unsigned* bar; unsigned x; volatile LAS unsigned* st; };
__device__ __forceinline__ XcdBarrier xcd_barrier_post(unsigned* bar, volatile LAS unsigned* st) {
    XcdBarrier b; b.bar = bar; b.x = xb_xcc_id(); b.st = st;
    if (threadIdx.x == 0) (void)xb_add(&bar[XB_XCNT(b.x)], 1u);
    return b;
}
__device__ __forceinline__ void xcd_barrier_complete(unsigned* bar, unsigned x, unsigned& nloc, unsigned& nx) {
    const unsigned G = gridDim.x * gridDim.y * gridDim.z;
    unsigned sum, cnt, mine, sp = 0u;
    for (;;) {
        sum = 0u; cnt = 0u; mine = 0u;
#pragma unroll
        for (unsigned j = 0; j < 16; ++j) { const unsigned c = xb_ld(&bar[XB_XCNT(j)]); sum += c; cnt += (c > 0u) ? 1u : 0u; mine = (j == x) ? c : mine; }
        if (sum == G) break;
        __builtin_amdgcn_s_sleep(1);
        if ((++sp & 255u) == 0u) { if (xb_ld(&bar[XB_TMO])) break; if (sp > XB_SPIN_CAP) { atomicAdd(&bar[XB_TMO], 1u); break; } }
    }
    nloc = mine > 0u ? mine : 1u; nx = cnt > 0u ? cnt : 1u;
}
__device__ __forceinline__ void xcd_barrier(const XcdBarrier& b) {
    asm volatile("s_waitcnt vmcnt(0)" ::: "memory");
    __syncthreads();
    if (threadIdx.x == 0) {
        unsigned* bar = b.bar;
        __builtin_amdgcn_s_waitcnt(0);
        unsigned nloc = b.st[0], nx = b.st[1];
        if (nloc == 0u) { xcd_barrier_complete(bar, b.x, nloc, nx); b.st[0] = nloc; b.st[1] = nx; }
        const unsigned old = xb_add(&bar[XB_XSUB(b.x)], 1u);
        const unsigned gen = old / nloc;
        if (old + 1u == (gen + 1u) * nloc) {
            __builtin_amdgcn_fence(__ATOMIC_RELEASE, "agent");
            asm volatile("s_waitcnt vmcnt(0)" ::: "memory");
            const unsigned og = xb_add(&bar[XB_TOP], 1u);
            const unsigned tg = og / nx;
            if (og + 1u == (tg + 1u) * nx) xb_add(&bar[XB_TOPGEN], 1u);
            else XB_SPIN(xb_ld(&bar[XB_TOPGEN]) == tg, bar);
            __builtin_amdgcn_fence(__ATOMIC_ACQUIRE, "agent");
            xb_add(&bar[XB_XGEN(b.x)], 1u);
            asm volatile("s_waitcnt vmcnt(0)" ::: "memory");
        } else {
            XB_SPIN(xb_ld(&bar[XB_XGEN(b.x)]) == gen, bar);
            __builtin_amdgcn_fence(__ATOMIC_ACQUIRE, "agent");
            asm volatile("s_waitcnt vmcnt(0)" ::: "memory");
        }
    }
    __syncthreads();
}

#ifndef PHASE_MASK
#define PHASE_MASK 0xffffu
#endif
#define PH(n) (((PHASE_MASK) >> (n)) & 1u)
struct Params { const float* in[24]; float* out; unsigned char* ws; };

__global__ void __launch_bounds__(NTHREADS, 2) fwd_megakernel(Params p) {
    extern __shared__ __attribute__((aligned(16))) unsigned char lds_raw[];
    LAS unsigned char* lds = (LAS unsigned char*)lds_raw;
    cg::grid_group grid = cg::this_grid();
    const int tid = threadIdx.x, lane = tid & 63, wave = __builtin_amdgcn_readfirstlane(tid >> 6);
    const int G = gridDim.x, bx = blockIdx.x;
    const int gw = bx * NWAVES + wave, NGW = G * NWAVES;
    unsigned char* ws = p.ws;
    const float* x = p.in[0];
    float* out = p.out;
    bf16_t* Wgu1 = (bf16_t*)(ws + WS_WGU1); bf16_t* Wd1 = (bf16_t*)(ws + WS_WD1); bf16_t* Win = (bf16_t*)(ws + WS_WIN); bf16_t* Wa = (bf16_t*)(ws + WS_WA); bf16_t* Wb = (bf16_t*)(ws + WS_WB);
    bf16_t* Wout = (bf16_t*)(ws + WS_WOUT); bf16_t* Wgu2 = (bf16_t*)(ws + WS_WGU2); bf16_t* Wd2 = (bf16_t*)(ws + WS_WD2); bf16_t* Wsb = (bf16_t*)(ws + WS_WSB);
    bf16_t* XB = (bf16_t*)(ws + WS_XB); bf16_t* Hb = (bf16_t*)(ws + WS_H); bf16_t* Ub = (bf16_t*)(ws + WS_U); bf16_t* Vb = (bf16_t*)(ws + WS_V); bf16_t* Zb = (bf16_t*)(ws + WS_Z);
    bf16_t* Gb = (bf16_t*)(ws + WS_G); bf16_t* Bo = (bf16_t*)(ws + WS_BOUT);
    float* stash = (float*)(ws + WS_STASH) + (size_t)bx * 65536;
    volatile LAS unsigned* bst = (volatile LAS unsigned*)(lds + 131072 + 320);
    if (tid < 4) bst[tid] = 0u;
    __syncthreads();
    const XcdBarrier xbar = xcd_barrier_post((unsigned*)(ws + WS_CTL), bst);
#define GRID_BAR() xcd_barrier(xbar)

    if (PH(0)) {
        LAS float* scr = (LAS float*)(lds + wave * 16384);
        p0_matrix(p.in[1], DM, 2 * FF, Wgu1, 1, scr, gw, NGW, lane);
        p0_matrix(p.in[2], FF, DM, Wd1, 0, scr, gw, NGW, lane);
        p0_matrix(p.in[5], DM, INC, Win, 2, scr, gw, NGW, lane);
        p0_matrix(p.in[11], AW, DM, Wa, 0, scr, gw, NGW, lane);
        p0_matrix(p.in[16], AW, DM, Wb, 0, scr, gw, NGW, lane);
        p0_matrix(p.in[17], DM, DM, Wout, 0, scr, gw, NGW, lane);
        p0_matrix(p.in[20], DM, 2 * FF, Wgu2, 1, scr, gw, NGW, lane);
        p0_matrix(p.in[21], FF, DM, Wd2, 0, scr, gw, NGW, lane);
        const size_t gt = (size_t)bx * NTHREADS + tid, GT = (size_t)G * NTHREADS;
        for (size_t i = gt; i < (size_t)MTOK * DM / 8; i += GT) {
            const f32x4 a = ((const f32x4*)x)[2 * i], b = ((const f32x4*)x)[2 * i + 1];
            u32x4 w; w.x = cvt_pk_bf16(a[0], a[1]); w.y = cvt_pk_bf16(a[2], a[3]); w.z = cvt_pk_bf16(b[0], b[1]); w.w = cvt_pk_bf16(b[2], b[3]);
            ((u32x4*)XB)[i] = w;
        }
        const float* wsf = p.in[9];
        for (size_t i = gt; i < (size_t)8 * 128 * 128 / 2; i += GT) {
            const int jj = (int)((2 * i) & 127), ii = (int)(((2 * i) >> 7) & 127);
            const f32x2 v = ((const f32x2*)wsf)[i];
            const bool keep = !(ii < 64 && jj >= 64);
            ((unsigned*)Wsb)[i] = keep ? cvt_pk_bf16(v[0], v[1]) : 0u;
        }
    }
    grid.sync();
    if (PH(1)) { pg8::Gemm g{XB, Wgu1, nullptr, nullptr, MTOK, 2 * FF, DM}; pg8::StaticOrder S; S.init(MTOK, 2 * FF, G, bx); pg8::EpiSwiGLU E{Hb}; pg8::gemm_phase(lds, g, S, E); }
    GRID_BAR();
    if (PH(2)) { pg8::Gemm g{Hb, Wd1, nullptr, nullptr, MTOK, DM, FF}; pg8::StaticOrder S; S.init(MTOK, DM, G, bx); pg8::EpiResid E{x, out, ALPHA, 0.5f}; pg8::gemm_phase(lds, g, S, E); }
    GRID_BAR();
    if (PH(3)) ln_phase(out, out, XB, p.in[3], p.in[4], gw, NGW, lane);
    GRID_BAR();
    if (PH(4)) { pg8::Gemm g{XB, Win, nullptr, nullptr, MTOK, INC, DM}; pg8::StaticOrder S; S.init(MTOK, INC, G, bx); pg8::EpiProj E{p.in[6], Ub, Vb, Zb, Gb}; pg8::gemm_phase(lds, g, S, E); }
    GRID_BAR();
    if (PH(5)) for (int blk = bx; blk < MTOK / 128; blk += G) sgu_item(lds, Vb, Ub, Wsb, p.in[10], p.in[7], p.in[8], blk, tid, wave, lane);
    __syncthreads();
    if (PH(6)) conv_items(lds, Zb, Bo, p.in[12], p.in[13], p.in[14], p.in[15], bx, G, tid, wave, lane);
    GRID_BAR();
    if (PH(7)) { pg8::Gemm g{Ub, Wa, Bo, Wb, MTOK, DM, AW}; pg8::DualOrder S; S.init(MTOK, DM, G, bx); pg8::EpiMix E{Gb, XB, stash}; pg8::gemm_phase(lds, g, S, E); }
    GRID_BAR();
    if (PH(8)) { pg8::Gemm g{XB, Wout, nullptr, nullptr, MTOK, DM, DM}; pg8::StaticOrder S; S.init(MTOK, DM, G, bx); pg8::EpiResid E{out, out, ALPHA, 1.0f}; pg8::gemm_phase(lds, g, S, E); }
    GRID_BAR();
    if (PH(9)) ln_phase(out, out, XB, p.in[18], p.in[19], gw, NGW, lane);
    GRID_BAR();
    if (PH(10)) { pg8::Gemm g{XB, Wgu2, nullptr, nullptr, MTOK, 2 * FF, DM}; pg8::StaticOrder S; S.init(MTOK, 2 * FF, G, bx); pg8::EpiSwiGLU E{Hb}; pg8::gemm_phase(lds, g, S, E); }
    GRID_BAR();
    if (PH(11)) { pg8::Gemm g{Hb, Wd2, nullptr, nullptr, MTOK, DM, FF}; pg8::StaticOrder S; S.init(MTOK, DM, G, bx); pg8::EpiResid E{out, out, ALPHA, 0.5f}; pg8::gemm_phase(lds, g, S, E); }
    GRID_BAR();
    if (PH(12)) ln_phase(out, out, nullptr, p.in[22], p.in[23], gw, NGW, lane);
}

extern "C" void kernel_launch(void* const* d_in, const int* in_sizes, int n_in, void* d_out, int out_size, void* d_ws, size_t ws_size, hipStream_t stream) {
    static int grid_blocks = 0;
    if (grid_blocks == 0) {
        if (n_in != 24 || out_size != MTOK * DM || ws_size < WS_END) { fprintf(stderr, "kernel_launch: unexpected shapes: n_in %d out %d ws %zu\n", n_in, out_size, ws_size); grid_blocks = -1; return; }
        int dev = 0, cus = 0, per_cu = 0;
        (void)hipGetDevice(&dev);
        (void)hipDeviceGetAttribute(&cus, hipDeviceAttributeMultiprocessorCount, dev);
        if (hipFuncSetAttribute((const void*)fwd_megakernel, hipFuncAttributeMaxDynamicSharedMemorySize, LDS_BYTES) != hipSuccess) { fprintf(stderr, "kernel_launch: hipFuncSetAttribute failed\n"); grid_blocks = -1; return; }
        if (hipOccupancyMaxActiveBlocksPerMultiprocessor(&per_cu, (const void*)fwd_megakernel, NTHREADS, LDS_BYTES) != hipSuccess || per_cu < 1) { fprintf(stderr, "kernel_launch: occupancy query gave %d\n", per_cu); per_cu = 1; (void)hipGetLastError(); }
        grid_blocks = cus * per_cu;
    }
    if (grid_blocks < 0) return;
    if (hipMemsetAsync((char*)d_ws + WS_CTL, 0, CTL_BYTES, stream) != hipSuccess) { fprintf(stderr, "kernel_launch: memset failed\n"); return; }
    Params p{};
    for (int i = 0; i < 24; ++i) p.in[i] = (const float*)d_in[i];
    p.out = (float*)d_out; p.ws = (unsigned char*)d_ws;
    void* args[] = {&p};
    hipError_t e = hipLaunchCooperativeKernel((const void*)fwd_megakernel, dim3(grid_blocks), dim3(NTHREADS), args, LDS_BYTES, stream);
    if (e != hipSuccess) fprintf(stderr, "kernel_launch: cooperative launch failed: %s (grid %d)\n", hipGetErrorString(e), grid_blocks);
}
```

```cpp
#include <hip/hip_runtime.h>
#include <hip/hip_cooperative_groups.h>
#include <cstdio>
#include <cstdint>
namespace cg = cooperative_groups;

#define LAS __attribute__((address_space(3)))
typedef unsigned short bf16_t;
typedef short bf16x8 __attribute__((ext_vector_type(8)));
typedef float f32x4 __attribute__((ext_vector_type(4)));
typedef float f32x2 __attribute__((ext_vector_type(2)));
typedef unsigned u32x4 __attribute__((ext_vector_type(4)));
typedef unsigned u32x2 __attribute__((ext_vector_type(2)));

constexpr int DM = 2048, MTOK = 4 * 8192, SEQ = 8192, FF = 5632, AW = 1024, INC = 8192;
constexpr float LN_EPS = 1e-5f, ALPHA = 1.189207115002721f;
constexpr int NWAVES = 8, NTHREADS = 512, LDS_BYTES = 147456;

constexpr size_t MiB = 1u << 20;
constexpr size_t WS_WGU1 = 0, WS_WD1 = 44 * MiB, WS_WIN = 66 * MiB, WS_WA = 98 * MiB, WS_WB = 102 * MiB, WS_WOUT = 106 * MiB, WS_WGU2 = 114 * MiB, WS_WD2 = 158 * MiB;
constexpr size_t WS_WSB = 180 * MiB, WS_CTL = 181 * MiB, CTL_BYTES = 16384, WS_STASH = 182 * MiB, WS_XB = 256 * MiB, WS_BIG = 384 * MiB, WS_BOUT = 832 * MiB, WS_END = 896 * MiB;
constexpr size_t WS_U = WS_BIG, WS_V = WS_BIG + 64 * MiB, WS_Z = WS_BIG + 128 * MiB, WS_G = WS_BIG + 192 * MiB, WS_H = WS_BIG;

__device__ __forceinline__ unsigned cvt_pk_bf16(float lo, float hi) { unsigned r; asm volatile("v_cvt_pk_bf16_f32 %0, %1, %2" : "=v"(r) : "v"(lo), "v"(hi)); return r; }
__device__ __forceinline__ float bf_lo(unsigned w) { return __uint_as_float(w << 16); }
__device__ __forceinline__ float bf_hi(unsigned w) { return __uint_as_float(w & 0xffff0000u); }
__device__ __forceinline__ float sigmoid_f(float y) { return __builtin_amdgcn_rcpf(1.0f + __builtin_amdgcn_exp2f(-1.4426950409f * y)); }
__device__ __forceinline__ float silu_f(float x) { return x * sigmoid_f(x); }
__device__ __forceinline__ float gelu_tanh_f(float x) { return x * sigmoid_f(1.5957691216f * (x + 0.044715f * x * x * x)); }
__device__ __forceinline__ float wave_sum(float v) {
#pragma unroll
    for (int o = 1; o < 64; o <<= 1) v += __shfl_xor(v, o);
    return v;
}

namespace pg8 {
constexpr int BM = 256, BK = 64, HALF = 128, HTB = HALF * BK * 2, STAGE_BYTES = 8 * HTB, NXCD = 8, WGM = 8;
__host__ __device__ __forceinline__ int lds_byte(int r, int c) { const int st = (r >> 4) * 2 + (c >> 5), rr = r & 15, cc = c & 31, ob = rr * 64 + cc * 2; return st * 1024 + (ob ^ (((ob >> 9) & 1) << 5)); }
__host__ __device__ __forceinline__ void stage_rc(int b, int& R, int& C) { const int st = b / 1024, sb = b % 1024, swz = sb ^ (((sb >> 9) & 1) << 5); R = (st >> 1) * 16 + swz / 64; C = (st & 1) * 32 + (swz % 64) / 2; }
__host__ __device__ __forceinline__ int perm32(int rho) { const int n = rho >> 4, i = rho & 15; return 8 * (i >> 2) + 4 * n + (i & 3); }

struct Unit { int pm, pn, z; };
struct Gemm { const bf16_t* A; const bf16_t* Bt; const bf16_t* A2; const bf16_t* Bt2; int M, N, K; };

struct StaticOrder {
    int nM, nN, nwg, G, c;
    __device__ void init(int M, int N, int G_, int c_) { nM = M / BM; nN = N / BM; nwg = nM * nN; G = G_; c = c_; }
    __device__ bool next(int i, Unit& u) const {
        const long L = (long)i * G + c; if (L >= nwg) return false;
        int wgid = (int)L; { const int q = nwg / NXCD, r = nwg % NXCD, xcd = wgid % NXCD, off = wgid / NXCD; wgid = (xcd < r ? xcd * (q + 1) : r * (q + 1) + (xcd - r) * q) + off; }
        const int nig = WGM * nN, gid = wgid / nig, fm = gid * WGM, gsz = (nM - fm) < WGM ? (nM - fm) : WGM;
        u.pm = fm + ((wgid % nig) % gsz); u.pn = (wgid % nig) / gsz; u.z = 0; return true;
    }
};
struct DualOrder {
    StaticOrder b;
    __device__ void init(int M, int N, int G_, int c_) { b.init(M, N, G_, c_); }
    __device__ bool next(int i, Unit& u) const { if (!b.next(i >> 1, u)) return false; u.z = i & 1; return true; }
};

template <class Epi, class Sched>
__device__ __forceinline__ void gemm_phase(LAS unsigned char* lds, const Gemm g, const Sched& S, const Epi& E) {
    int tid_ = threadIdx.x; asm volatile("" : "+v"(tid_));
    const int tid = tid_, wid = __builtin_amdgcn_readfirstlane(tid >> 6), lane = tid & 63, wr = wid >> 2, wc = wid & 3, fr = lane & 15, fq = lane >> 4;
    const int K = g.K, nt = K / BK;
    unsigned voffA[2], voffB[2];
#pragma unroll
    for (int i = 0; i < 2; ++i) { int R, C; stage_rc(tid * 16 + i * 8192, R, C); const int Rb = Epi::PERM ? ((R & ~31) + perm32(R & 31)) : R;
        voffA[i] = (unsigned)(R * K + C) * 2u; voffB[i] = (unsigned)(Rb * K + C) * 2u; }
    const size_t kstep = (size_t)(BK * 2);
    const size_t hstep = (size_t)HALF * K * 2;
    const size_t tstep = 2 * hstep;
    const unsigned ldsw = (unsigned)wid * 1024u;
    const int aoff = lds_byte(wr * 64 + fr, fq * 8), boff = lds_byte(wc * 32 + fr, fq * 8);
#define PG8_SA(b, h) (((b) * 2 + (h)) * HTB)
#define PG8_SB(b, h) ((4 + (b) * 2 + (h)) * HTB)
#define PG8_STAGE(bufoff, gbase, voff) do { _Pragma("unroll") for (int _i = 0; _i < 2; ++_i) \
        __builtin_amdgcn_global_load_lds((const unsigned*)((const char*)(gbase) + (voff)[_i]), (LAS unsigned*)(lds + (bufoff) + ldsw + _i * 8192), 16, 0, 0); } while (0)
#define PG8_LDA(dst, b, h) do { _Pragma("unroll") for (int m = 0; m < 4; ++m) _Pragma("unroll") for (int k = 0; k < 2; ++k) dst[m][k] = *(const LAS bf16x8*)(lds + PG8_SA(b, h) + aoff + m * 2048 + k * 1024); } while (0)
#define PG8_LDB(dst, b, h) do { _Pragma("unroll") for (int n = 0; n < 2; ++n) _Pragma("unroll") for (int k = 0; k < 2; ++k) dst[n][k] = *(const LAS bf16x8*)(lds + PG8_SB(b, h) + boff + n * 2048 + k * 1024); } while (0)
#define PG8_MMA(ai, bj, At, Bt) do { __builtin_amdgcn_s_setprio(1); _Pragma("unroll") for (int m = 0; m < 4; ++m) _Pragma("unroll") for (int n = 0; n < 2; ++n) _Pragma("unroll") for (int k = 0; k < 2; ++k) \
        acc[ai][bj][m][n] = __builtin_amdgcn_mfma_f32_16x16x32_bf16(Bt[n][k], At[m][k], acc[ai][bj][m][n], 0, 0, 0); __builtin_amdgcn_s_setprio(0); } while (0)
#define PG8_WAIT_V(n) asm volatile("s_waitcnt vmcnt(" #n ")" ::: "memory")
#define PG8_WAIT_L(n) asm volatile("s_waitcnt lgkmcnt(" #n ")" ::: "memory")
#define PG8_BAR __builtin_amdgcn_s_barrier()
#define PG8_SCHED __builtin_amdgcn_sched_barrier(0)
    Unit cur, nxt; int ui = 0;
    if (!S.next(0, cur)) return;
    f32x4 acc[2][2][4][2];
#pragma unroll
    for (int a = 0; a < 2; ++a)
#pragma unroll
        for (int b = 0; b < 2; ++b)
#pragma unroll
            for (int m = 0; m < 4; ++m)
#pragma unroll
                for (int n = 0; n < 2; ++n) acc[a][b][m][n] = (f32x4){0.f, 0.f, 0.f, 0.f};
    bf16x8 At[4][2], B0[2][2], B1[2][2];
    const char* cA = (const char*)(cur.z ? g.A2 : g.A) + (size_t)cur.pm * tstep; const char* cB = (const char*)(cur.z ? g.Bt2 : g.Bt) + (size_t)cur.pn * tstep;
    PG8_STAGE(PG8_SB(0, 0), cB, voffB); PG8_STAGE(PG8_SB(0, 1), cB + hstep, voffB); PG8_STAGE(PG8_SA(0, 0), cA, voffA); PG8_STAGE(PG8_SA(0, 1), cA + hstep, voffA);
    if (wr == 1) PG8_BAR;
    PG8_WAIT_V(2); PG8_BAR;
    PG8_STAGE(PG8_SB(1, 0), cB + kstep, voffB); PG8_STAGE(PG8_SA(1, 0), cA + kstep, voffA); PG8_STAGE(PG8_SB(1, 1), cB + hstep + kstep, voffB);
    PG8_WAIT_V(6); PG8_BAR;
    for (;;) {
        const bool has_next = S.next(ui + 1, nxt);
        const char* nA = has_next ? (const char*)(nxt.z ? g.A2 : g.A) + (size_t)nxt.pm * tstep : cA; const char* nB = has_next ? (const char*)(nxt.z ? g.Bt2 : g.Bt) + (size_t)nxt.pn * tstep : cB;
        for (int t = 0; t < nt; t += 2) {
            const bool last = (t == nt - 2);
            const char* a1 = cA + (size_t)(t + 1) * kstep;
            const char* a2 = last ? nA : cA + (size_t)(t + 2) * kstep; const char* b2 = last ? nB : cB + (size_t)(t + 2) * kstep;
            const char* a3 = a2 + kstep; const char* b3 = b2 + kstep;
            PG8_LDB(B0, 0, 0); PG8_LDB(B1, 0, 1); PG8_SCHED; PG8_LDA(At, 0, 0); PG8_STAGE(PG8_SA(1, 1), a1 + hstep, voffA);
            PG8_WAIT_V(8); PG8_WAIT_L(0); PG8_BAR; PG8_MMA(0, 0, At, B0); PG8_MMA(0, 1, At, B1); PG8_BAR; PG8_SCHED;
            PG8_LDA(At, 0, 1); PG8_STAGE(PG8_SB(0, 0), b2, voffB); PG8_STAGE(PG8_SB(0, 1), b2 + hstep, voffB); PG8_STAGE(PG8_SA(0, 0), a2, voffA);
            PG8_WAIT_V(8); PG8_WAIT_L(0); PG8_BAR; PG8_MMA(1, 0, At, B0); PG8_MMA(1, 1, At, B1); PG8_BAR; PG8_SCHED;
            PG8_LDB(B0, 1, 0); PG8_LDB(B1, 1, 1); PG8_SCHED; PG8_LDA(At, 1, 0); PG8_STAGE(PG8_SA(0, 1), a2 + hstep, voffA);
            PG8_WAIT_V(8); PG8_WAIT_L(0); PG8_BAR; PG8_MMA(0, 0, At, B0); PG8_MMA(0, 1, At, B1); PG8_BAR; PG8_SCHED;
            PG8_LDA(At, 1, 1); PG8_STAGE(PG8_SB(1, 0), b3, voffB); PG8_STAGE(PG8_SB(1, 1), b3 + hstep, voffB); PG8_STAGE(PG8_SA(1, 0), a3, voffA);
            PG8_WAIT_V(8); PG8_WAIT_L(0); PG8_BAR; PG8_MMA(1, 0, At, B0); PG8_MMA(1, 1, At, B1); PG8_BAR; PG8_SCHED;
        }
        if (wr == 0) PG8_BAR;
        E(acc, cur, wr, wc, fr, fq);
        if (!has_next) break;
#pragma unroll
        for (int a = 0; a < 2; ++a)
#pragma unroll
            for (int b = 0; b < 2; ++b)
#pragma unroll
                for (int m = 0; m < 4; ++m)
#pragma unroll
                    for (int n = 0; n < 2; ++n) acc[a][b][m][n] = (f32x4){0.f, 0.f, 0.f, 0.f};
        cur = nxt; cA = nA; cB = nB; ++ui;
        if (wr == 1) PG8_BAR;
    }
    PG8_WAIT_V(0);
    PG8_BAR;
#undef PG8_SA
#undef PG8_SB
#undef PG8_STAGE
#undef PG8_LDA
#undef PG8_LDB
#undef PG8_MMA
#undef PG8_WAIT_V
#undef PG8_WAIT_L
#undef PG8_BAR
#undef PG8_SCHED
}

struct EpiSwiGLU {
    static constexpr bool PERM = true;
    bf16_t* H;
    __device__ __forceinline__ void operator()(const f32x4 (&acc)[2][2][4][2], const Unit& u, int wr, int wc, int fr, int fq) const {
        const int row0 = u.pm * BM + wr * 64 + fr, col0 = u.pn * HALF + wc * 32 + 8 * fq;
#pragma unroll
        for (int ai = 0; ai < 2; ++ai)
#pragma unroll
            for (int m = 0; m < 4; ++m) {
                bf16_t* rowp = H + (size_t)(row0 + ai * HALF + m * 16) * FF + col0;
                const f32x4 g0 = acc[ai][0][m][0], g1 = acc[ai][0][m][1], u0 = acc[ai][1][m][0], u1 = acc[ai][1][m][1];
                u32x4 w;
                w.x = cvt_pk_bf16(silu_f(g0[0]) * u0[0], silu_f(g0[1]) * u0[1]); w.y = cvt_pk_bf16(silu_f(g0[2]) * u0[2], silu_f(g0[3]) * u0[3]);
                w.z = cvt_pk_bf16(silu_f(g1[0]) * u1[0], silu_f(g1[1]) * u1[1]); w.w = cvt_pk_bf16(silu_f(g1[2]) * u1[2], silu_f(g1[3]) * u1[3]);
                *(u32x4*)rowp = w;
            }
    }
};
template <bool LN> struct EpiRes {
    static constexpr bool PERM = false;
    const float* res; const f32x2* stats; const float* g; const float* b; float* out; float alpha, scale;
    __device__ __forceinline__ void operator()(const f32x4 (&acc)[2][2][4][2], const Unit& u, int wr, int wc, int fr, int fq) const {
        const int row0 = u.pm * BM + wr * 64 + fr, col0 = u.pn * BM + wc * 32 + 4 * fq;
#pragma unroll
        for (int ai = 0; ai < 2; ++ai) {
            f32x4 r[4][2][2]; float a1[4], a0[4];
#pragma unroll
            for (int m = 0; m < 4; ++m) {
                const int row = row0 + ai * HALF + m * 16;
                const size_t off = (size_t)row * DM + col0;
                if (LN) { const f32x2 st = stats[row]; a1[m] = alpha * st[1]; a0[m] = -st[0] * a1[m]; } else { a1[m] = alpha; a0[m] = 0.f; }
#pragma unroll
                for (int bj = 0; bj < 2; ++bj)
#pragma unroll
                    for (int n = 0; n < 2; ++n) r[m][bj][n] = *(const f32x4*)(res + off + bj * HALF + n * 16);
            }
#pragma unroll
            for (int bj = 0; bj < 2; ++bj)
#pragma unroll
                for (int n = 0; n < 2; ++n) {
                    f32x4 gv = (f32x4){1.f, 1.f, 1.f, 1.f}, bv = (f32x4){0.f, 0.f, 0.f, 0.f};
                    if (LN) { gv = *(const f32x4*)(g + col0 + bj * HALF + n * 16); bv = *(const f32x4*)(b + col0 + bj * HALF + n * 16) * alpha; }
#pragma unroll
                    for (int m = 0; m < 4; ++m) {
                        const size_t off = (size_t)(row0 + ai * HALF + m * 16) * DM + col0;
                        f32x4 x = r[m][bj][n] * a1[m] + a0[m];
                        if (LN) x = x * gv + bv;
                        *(f32x4*)(out + off + bj * HALF + n * 16) = x + acc[ai][bj][m][n] * scale;
                    }
                }
            asm volatile("" ::: "memory");
        }
    }
};
struct EpiProj {
    static constexpr bool PERM = true;
    const float* bias; bf16_t *U, *V, *Z, *G;
    __device__ __forceinline__ void operator()(const f32x4 (&acc)[2][2][4][2], const Unit& u, int wr, int wc, int fr, int fq) const {
        const int row0 = u.pm * BM + wr * 64 + fr, cw = wc * 32 + 8 * fq;
        if (u.pn >= 8 && u.pn < 16) {
            const int jt = u.pn - 8;
            const f32x4 ba0 = *(const f32x4*)(bias + 2048 + 128 * jt + cw), ba1 = *(const f32x4*)(bias + 2048 + 128 * jt + cw + 4);
            const f32x4 bg0 = *(const f32x4*)(bias + 3072 + 128 * jt + cw), bg1 = *(const f32x4*)(bias + 3072 + 128 * jt + cw + 4);
#pragma unroll
            for (int ai = 0; ai < 2; ++ai)
#pragma unroll
                for (int m = 0; m < 4; ++m) {
                    bf16_t* rowp = Z + (size_t)(row0 + ai * HALF + m * 16) * AW + 128 * jt + cw;
                    const f32x4 a0 = acc[ai][0][m][0] + ba0, a1 = acc[ai][0][m][1] + ba1, g0 = acc[ai][1][m][0] + bg0, g1 = acc[ai][1][m][1] + bg1;
                    u32x4 w;
                    w.x = cvt_pk_bf16(a0[0] * sigmoid_f(g0[0]), a0[1] * sigmoid_f(g0[1])); w.y = cvt_pk_bf16(a0[2] * sigmoid_f(g0[2]), a0[3] * sigmoid_f(g0[3]));
                    w.z = cvt_pk_bf16(a1[0] * sigmoid_f(g1[0]), a1[1] * sigmoid_f(g1[1])); w.w = cvt_pk_bf16(a1[2] * sigmoid_f(g1[2]), a1[3] * sigmoid_f(g1[3]));
                    *(u32x4*)rowp = w;
                }
        } else {
            const bool is_gate = u.pn >= 16;
            bf16_t* base; int ldc, colt;
            if (is_gate) { base = G; ldc = 4096; colt = (u.pn - 16) * BM; } else if (u.pn < 4) { base = U; ldc = AW; colt = u.pn * BM; } else { base = V; ldc = AW; colt = (u.pn - 4) * BM; }
            f32x4 bv[2][2];
#pragma unroll
            for (int bj = 0; bj < 2; ++bj)
#pragma unroll
                for (int n = 0; n < 2; ++n) bv[bj][n] = *(const f32x4*)(bias + u.pn * BM + bj * HALF + cw + 4 * n);
#pragma unroll
            for (int ai = 0; ai < 2; ++ai)
#pragma unroll
                for (int m = 0; m < 4; ++m) {
                    bf16_t* rowp = base + (size_t)(row0 + ai * HALF + m * 16) * ldc + colt + cw;
#pragma unroll
                    for (int bj = 0; bj < 2; ++bj) {
                        const f32x4 v0 = acc[ai][bj][m][0] + bv[bj][0], v1 = acc[ai][bj][m][1] + bv[bj][1];
                        u32x4 w;
                        if (is_gate) {
                            w.x = cvt_pk_bf16(sigmoid_f(v0[0]), sigmoid_f(v0[1])); w.y = cvt_pk_bf16(sigmoid_f(v0[2]), sigmoid_f(v0[3]));
                            w.z = cvt_pk_bf16(sigmoid_f(v1[0]), sigmoid_f(v1[1])); w.w = cvt_pk_bf16(sigmoid_f(v1[2]), sigmoid_f(v1[3]));
                        } else {
                            w.x = cvt_pk_bf16(gelu_tanh_f(v0[0]), gelu_tanh_f(v0[1])); w.y = cvt_pk_bf16(gelu_tanh_f(v0[2]), gelu_tanh_f(v0[3]));
                            w.z = cvt_pk_bf16(gelu_tanh_f(v1[0]), gelu_tanh_f(v1[1])); w.w = cvt_pk_bf16(gelu_tanh_f(v1[2]), gelu_tanh_f(v1[3]));
                        }
                        *(u32x4*)(rowp + bj * HALF) = w;
                    }
                }
        }
    }
};
struct EpiMix {
    static constexpr bool PERM = true;
    const bf16_t* G; bf16_t* Mx; float* stash;
    __device__ __forceinline__ void operator()(const f32x4 (&acc)[2][2][4][2], const Unit& u, int wr, int wc, int fr, int fq) const {
        const int row0 = u.pm * BM + wr * 64 + fr, col0 = u.pn * BM + wc * 32 + 8 * fq;
        float* sp = stash + (size_t)threadIdx.x * 4;
        asm volatile("" : "+v"(sp));
        const bf16_t* gp = G + (size_t)row0 * 4096 + (u.z ? 2048 : 0) + col0;
        bf16_t* mp = Mx + (size_t)row0 * DM + col0;
#pragma unroll
        for (int ai = 0; ai < 2; ++ai)
#pragma unroll
            for (int mh = 0; mh < 2; ++mh) {
                u32x4 gw[2][2]; f32x4 sv[2][2][2];
#pragma unroll
                for (int mm = 0; mm < 2; ++mm)
#pragma unroll
                    for (int bj = 0; bj < 2; ++bj) {
                        gw[mm][bj] = *(const u32x4*)(gp + (size_t)(ai * HALF + (mh * 2 + mm) * 16) * 4096 + bj * HALF);
                        if (u.z) { const float* q = sp + (size_t)(((ai * 4 + mh * 2 + mm) * 2 + bj) * 4096); sv[mm][bj][0] = *(const f32x4*)q; sv[mm][bj][1] = *(const f32x4*)(q + 2048); }
                    }
#pragma unroll
                for (int mm = 0; mm < 2; ++mm)
#pragma unroll
                    for (int bj = 0; bj < 2; ++bj) {
                        const int m = mh * 2 + mm;
                        const u32x4 w = gw[mm][bj];
                        const f32x4 ga = (f32x4){bf_lo(w.x), bf_hi(w.x), bf_lo(w.y), bf_hi(w.y)}, gb = (f32x4){bf_lo(w.z), bf_hi(w.z), bf_lo(w.w), bf_hi(w.w)};
                        f32x4 v0 = acc[ai][bj][m][0] * ga, v1 = acc[ai][bj][m][1] * gb;
                        if (u.z == 0) { float* q = sp + (size_t)(((ai * 4 + m) * 2 + bj) * 4096); *(f32x4*)q = v0; *(f32x4*)(q + 2048) = v1; }
                        else {
                            v0 += sv[mm][bj][0]; v1 += sv[mm][bj][1];
                            u32x4 o; o.x = cvt_pk_bf16(v0[0], v0[1]); o.y = cvt_pk_bf16(v0[2], v0[3]); o.z = cvt_pk_bf16(v1[0], v1[1]); o.w = cvt_pk_bf16(v1[2], v1[3]);
                            *(u32x4*)(mp + (size_t)(ai * HALF + m * 16) * DM + bj * HALF) = o;
                        }
                    }
                asm volatile("" ::: "memory");
            }
    }
};
}

__device__ __forceinline__ void p0_transpose_item(const float* W, int K, int N, bf16_t* WT, int k0, int n0, int drow0, LAS float* scr, int lane) {
    const float* src = W + (size_t)(k0 + (lane >> 3)) * N + n0 + (lane & 7) * 4;
    f32x4 v[8];
#pragma unroll
    for (int i = 0; i < 8; ++i) v[i] = *(const f32x4*)(src + (size_t)(8 * i) * N);
    LAS float* sw = scr + (lane >> 3) * 33 + (lane & 7) * 4;
#pragma unroll
    for (int i = 0; i < 8; ++i) { sw[(8 * i) * 33 + 0] = v[i][0]; sw[(8 * i) * 33 + 1] = v[i][1]; sw[(8 * i) * 33 + 2] = v[i][2]; sw[(8 * i) * 33 + 3] = v[i][3]; }
    asm volatile("s_waitcnt lgkmcnt(0)" ::: "memory");
    const int c = lane & 7;
#pragma unroll
    for (int j = 0; j < 4; ++j) { const int n = (lane >> 3) + 8 * j; const LAS float* s = scr + (8 * c) * 33 + n;
        u32x4 o; o.x = cvt_pk_bf16(s[0 * 33], s[1 * 33]); o.y = cvt_pk_bf16(s[2 * 33], s[3 * 33]); o.z = cvt_pk_bf16(s[4 * 33], s[5 * 33]); o.w = cvt_pk_bf16(s[6 * 33], s[7 * 33]);
        *(u32x4*)(WT + (size_t)(drow0 + n) * K + k0 + 8 * c) = o; }
    asm volatile("s_waitcnt lgkmcnt(0)" ::: "memory");
}
__device__ __forceinline__ int dest_row(int mode, int n0) {
    if (mode == 1) { const int half = n0 >= FF ? 1 : 0, j = n0 - half * FF; return 256 * (j >> 7) + 128 * half + (j & 127); }
    if (mode == 2) { if (n0 < 2048 || n0 >= 4096) return n0; const int half = n0 >= 3072 ? 1 : 0, j = n0 - 2048 - 1024 * half; return 2048 + 256 * (j >> 7) + 128 * half + (j & 127); }
    return n0;
}
__device__ __forceinline__ void p0_matrix(const float* W, int K, int N, bf16_t* WT, int mode, LAS float* scr, int gw, int NGW, int lane) {
    const int nblk = N / 32, nitems = (K / 64) * nblk;
    const int nkb = K / 64;
    for (int it = gw; it < nitems; it += NGW) { const int nb = it / nkb, kb = it - nb * nkb;     p0_transpose_item(W, K, N, WT, 64 * kb, 32 * nb, dest_row(mode, 32 * nb), scr, lane); }
}

__device__ __forceinline__ void ln_phase(const float* in, float* outf, bf16_t* outb, f32x2* stats, const float* g, const float* b, int gw, int NGW, int lane) {
    f32x4 gv[8], bv[8];
#pragma unroll
    for (int j = 0; j < 8; ++j) { gv[j] = ((const f32x4*)g)[lane + 64 * j]; bv[j] = ((const f32x4*)b)[lane + 64 * j]; }
    f32x4 nv[8];
    if (gw < MTOK) { const f32x4* xr = (const f32x4*)(in + (size_t)gw * DM) + lane;
#pragma unroll
        for (int j = 0; j < 8; ++j) nv[j] = xr[64 * j]; }
    for (int m = gw; m < MTOK; m += NGW) {
        f32x4 v[8]; float s = 0.f;
#pragma unroll
        for (int j = 0; j < 8; ++j) { v[j] = nv[j]; s += (v[j][0] + v[j][1]) + (v[j][2] + v[j][3]); }
        if (m + NGW < MTOK) { const f32x4* xn = (const f32x4*)(in + (size_t)(m + NGW) * DM) + lane;
#pragma unroll
            for (int j = 0; j < 8; ++j) nv[j] = xn[64 * j]; }
        const float mean = wave_sum(s) * (1.f / DM); float s2 = 0.f;
#pragma unroll
        for (int j = 0; j < 8; ++j) { v[j] = v[j] - mean; s2 += (v[j][0] * v[j][0] + v[j][1] * v[j][1]) + (v[j][2] * v[j][2] + v[j][3] * v[j][3]); }
        const float rstd = 1.f / sqrtf(wave_sum(s2) * (1.f / DM) + LN_EPS);
        if (stats && lane == 0) stats[m] = (f32x2){mean, rstd};
#pragma unroll
        for (int j = 0; j < 8; ++j) v[j] = v[j] * rstd * gv[j] + bv[j];
        if (outf) { f32x4* of = (f32x4*)(outf + (size_t)m * DM) + lane;
#pragma unroll
            for (int j = 0; j < 8; ++j) of[64 * j] = v[j]; }
        if (outb) {
            u32x2* ob = (u32x2*)(outb + (size_t)m * DM) + lane;
#pragma unroll
            for (int j = 0; j < 8; ++j) { u32x2 w; w.x = cvt_pk_bf16(v[j][0], v[j][1]); w.y = cvt_pk_bf16(v[j][2], v[j][3]); ob[64 * j] = w; }
        }
    }
}

__device__ __forceinline__ void sgu_item(LAS unsigned char* lds, const bf16_t* V, bf16_t* U, const bf16_t* Wsb, const float* bs, const float* lng, const float* lnb, int blk, int tid, int wave, int lane) {
    LAS float* st_mean = (LAS float*)lds; LAS float* st_rstd = st_mean + 128;
    LAS bf16_t* VnT = (LAS bf16_t*)(lds + 1024);
    const size_t t0 = (size_t)blk * 128;
#pragma unroll 4
    for (int rr = 0; rr < 16; ++rr) {
        const int row = wave * 16 + rr;
        const u32x4* vp = (const u32x4*)(V + (t0 + row) * AW) + lane;
        const u32x4 a = vp[0], b = vp[64];
        float s = ((bf_lo(a.x) + bf_hi(a.x)) + (bf_lo(a.y) + bf_hi(a.y))) + ((bf_lo(a.z) + bf_hi(a.z)) + (bf_lo(a.w) + bf_hi(a.w)))
                + ((bf_lo(b.x) + bf_hi(b.x)) + (bf_lo(b.y) + bf_hi(b.y))) + ((bf_lo(b.z) + bf_hi(b.z)) + (bf_lo(b.w) + bf_hi(b.w)));
        const float mean = wave_sum(s) * (1.f / AW);
        float q = 0.f;
#define SQ_(w) { const float d0 = bf_lo(w) - mean, d1 = bf_hi(w) - mean; q += d0 * d0 + d1 * d1; }
        SQ_(a.x) SQ_(a.y) SQ_(a.z) SQ_(a.w) SQ_(b.x) SQ_(b.y) SQ_(b.z) SQ_(b.w)
#undef SQ_
        const float rstd = 1.f / sqrtf(wave_sum(q) * (1.f / AW) + LN_EPS);
        if (lane == 0) { st_mean[row] = mean; st_rstd[row] = rstd; }
    }
    __syncthreads();
    const int j = tid & 127, chunk = wave >> 1;
    const float mj = st_mean[j], rj = st_rstd[j];
    const int r = lane & 15, q4 = lane >> 4;
    for (int h = 0; h < 8; ++h) {
        const int cb = h * 128 + chunk * 32;
        const u32x4* vp = (const u32x4*)(V + (t0 + j) * AW + cb);
        LAS bf16_t* dst = VnT + (chunk * 32) * 136 + j;
#pragma unroll
        for (int qd = 0; qd < 4; ++qd) {
            const u32x4 vv = vp[qd];
#pragma unroll
            for (int e = 0; e < 4; ++e) {
                const unsigned w = vv[e]; const int d = qd * 8 + e * 2;
                const float y0 = (bf_lo(w) - mj) * rj * lng[cb + d] + lnb[cb + d], y1 = (bf_hi(w) - mj) * rj * lng[cb + d + 1] + lnb[cb + d + 1];
                const unsigned pk = cvt_pk_bf16(y0, y1);
                dst[d * 136] = (bf16_t)(pk & 0xffffu); dst[(d + 1) * 136] = (bf16_t)(pk >> 16);
            }
        }
        __syncthreads();
        bf16x8 wf[4];
#pragma unroll
        for (int kk = 0; kk < 4; ++kk) wf[kk] = *(const bf16x8*)(Wsb + ((size_t)(h * 128 + wave * 16 + r) * 128 + kk * 32 + q4 * 8));
        const float bsi = bs[h * 128 + wave * 16 + r];
        bf16_t* urow = U + (t0 + wave * 16 + r) * AW + h * 128 + 4 * q4;
#pragma unroll
        for (int dt = 0; dt < 8; ++dt) {
            f32x4 acc = (f32x4){0.f, 0.f, 0.f, 0.f};
#pragma unroll
            for (int kk = 0; kk < 4; ++kk) { const bf16x8 vf = *(const LAS bf16x8*)(VnT + (dt * 16 + r) * 136 + kk * 32 + q4 * 8); acc = __builtin_amdgcn_mfma_f32_16x16x32_bf16(vf, wf[kk], acc, 0, 0, 0); }
            const u32x2 uu = *(const u32x2*)(urow + dt * 16);
            u32x2 o; o.x = cvt_pk_bf16(bf_lo(uu.x) * (acc[0] + bsi), bf_hi(uu.x) * (acc[1] + bsi)); o.y = cvt_pk_bf16(bf_lo(uu.y) * (acc[2] + bsi), bf_hi(uu.y) * (acc[3] + bsi));
            *(u32x2*)(urow + dt * 16) = o;
        }
        __syncthreads();
    }
}

__device__ __forceinline__ void conv_items(LAS unsigned char* lds, const bf16_t* Z, bf16_t* Bout, const float* wdw, const float* bdw, const float* lng, const float* lnb, int first, int stride, int tid, int wave, int lane) {
    LAS float* red = (LAS float*)lds;
    LAS float* tot = red + 256;
    const int c0 = 2 * tid;
    f32x2 w[31];
#pragma unroll
    for (int k = 0; k < 31; ++k) w[k] = *(const f32x2*)(wdw + k * AW + c0);
    const f32x2 bb = *(const f32x2*)(bdw + c0), gg = *(const f32x2*)(lng + c0), be = *(const f32x2*)(lnb + c0);
    for (int item = first; item < MTOK / 16; item += stride) {
        const size_t m0 = (size_t)item * 16; const int s0 = (int)(m0 & (SEQ - 1));
        f32x2 acc[16];
#pragma unroll
        for (int t = 0; t < 16; ++t) acc[t] = bb;
        const bf16_t* zp = Z + m0 * AW + c0;
#pragma unroll
        for (int idx = 0; idx < 46; ++idx) {
            unsigned zw = 0u;
            if (s0 + idx >= 30) zw = *(const unsigned*)(zp + (ptrdiff_t)(idx - 30) * AW);
            const f32x2 z = (f32x2){bf_lo(zw), bf_hi(zw)};
#pragma unroll
            for (int t = 0; t < 16; ++t) { if (idx - t >= 0 && idx - t <= 30) acc[t] += w[idx - t] * z; }
        }
#pragma unroll
        for (int t = 0; t < 16; ++t) {
            const float a = wave_sum(acc[t][0] + acc[t][1]), b = wave_sum(acc[t][0] * acc[t][0] + acc[t][1] * acc[t][1]);
            if (lane == 0) { red[wave * 32 + 2 * t] = a; red[wave * 32 + 2 * t + 1] = b; }
        }
        __syncthreads();
        if (tid < 32) { float s = 0.f;
#pragma unroll
            for (int wv = 0; wv < 8; ++wv) s += red[wv * 32 + tid];
            tot[tid] = s; }
        __syncthreads();
#pragma unroll
        for (int t = 0; t < 16; ++t) {
            const float mean = tot[2 * t] * (1.f / AW), var = tot[2 * t + 1] * (1.f / AW) - mean * mean, rstd = 1.f / sqrtf(var + LN_EPS);
            const f32x2 y = (acc[t] - mean) * rstd * gg + be;
            *(unsigned*)(Bout + (m0 + t) * AW + c0) = cvt_pk_bf16(silu_f(y[0]), silu_f(y[1]));
        }
        __syncthreads();
    }
}


#define XB_TMO      128
#define XB_XCNT(j)  (256  + 64 * (j))
#define XB_XSUB(j)  (1280 + 64 * (j))
#define XB_XGEN(j)  (2304 + 64 * (j))
#define XB_TOP      3328
#define XB_TOPGEN   3392
#define XCD_BAR_WORDS 3456
#define XB_SPIN_CAP (1u << 22)
__device__ __forceinline__ unsigned xb_ld(unsigned* p)              { return __hip_atomic_load(p, __ATOMIC_RELAXED, __HIP_MEMORY_SCOPE_AGENT); }
__device__ __forceinline__ unsigned xb_add(unsigned* p, unsigned v) { return __hip_atomic_fetch_add(p, v, __ATOMIC_RELAXED, __HIP_MEMORY_SCOPE_AGENT); }
__device__ __forceinline__ unsigned xb_xcc_id() { return (unsigned)__builtin_amdgcn_s_getreg((3 << 11) | 20) & 0xFu; }
#define XB_SPIN(cond, bar) do { unsigned _sp = 0; while (cond) { __builtin_amdgcn_s_sleep(1); \
    if ((++_sp & 255u) == 0u) { if (xb_ld(&(bar)[XB_TMO])) break; if (_sp > XB_SPIN_CAP) { atomicAdd(&(bar)[XB_TMO], 1u); break; } } } } while (0)
struct XcdBarrier { unsigned* bar; unsigned x; volatile LAS unsigned* st; };
__device__ __forceinline__ XcdBarrier xcd_barrier_post(unsigned* bar, volatile LAS unsigned* st) {
    XcdBarrier b; b.bar = bar; b.x = xb_xcc_id(); b.st = st;
    if (threadIdx.x == 0) (void)xb_add(&bar[XB_XCNT(b.x)], 1u);
    return b;
}
__device__ __forceinline__ void xcd_barrier_complete(unsigned* bar, unsigned x, unsigned& nloc, unsigned& nx) {
    const unsigned G = gridDim.x * gridDim.y * gridDim.z;
    unsigned sum, cnt, mine, sp = 0u;
    for (;;) {
        sum = 0u; cnt = 0u; mine = 0u;
#pragma unroll
        for (unsigned j = 0; j < 16; ++j) { const unsigned c = xb_ld(&bar[XB_XCNT(j)]); sum += c; cnt += (c > 0u) ? 1u : 0u; mine = (j == x) ? c : mine; }
        if (sum == G) break;
        __builtin_amdgcn_s_sleep(1);
        if ((++sp & 255u) == 0u) { if (xb_ld(&bar[XB_TMO])) break; if (sp > XB_SPIN_CAP) { atomicAdd(&bar[XB_TMO], 1u); break; } }
    }
    nloc = mine > 0u ? mine : 1u; nx = cnt > 0u ? cnt : 1u;
}
__device__ __forceinline__ void xcd_barrier(const XcdBarrier& b) {
    asm volatile("s_waitcnt vmcnt(0)" ::: "memory");
    __syncthreads();
    if (threadIdx.x == 0) {
        unsigned* bar = b.bar;
        __builtin_amdgcn_s_waitcnt(0);
        unsigned nloc = b.st[0], nx = b.st[1];
        if (nloc == 0u) { xcd_barrier_complete(bar, b.x, nloc, nx); b.st[0] = nloc; b.st[1] = nx; }
        const unsigned old = xb_add(&bar[XB_XSUB(b.x)], 1u);
        const unsigned gen = old / nloc;
        if (old + 1u == (gen + 1u) * nloc) {
            __builtin_amdgcn_fence(__ATOMIC_RELEASE, "agent");
            asm volatile("s_waitcnt vmcnt(0)" ::: "memory");
            const unsigned og = xb_add(&bar[XB_TOP], 1u);
            const unsigned tg = og / nx;
            if (og + 1u == (tg + 1u) * nx) xb_add(&bar[XB_TOPGEN], 1u);
            else XB_SPIN(xb_ld(&bar[XB_TOPGEN]) == tg, bar);
            __builtin_amdgcn_fence(__ATOMIC_ACQUIRE, "agent");
            xb_add(&bar[XB_XGEN(b.x)], 1u);
            asm volatile("s_waitcnt vmcnt(0)" ::: "memory");
        } else {
            XB_SPIN(xb_ld(&bar[XB_XGEN(b.x)]) == gen, bar);
            __builtin_amdgcn_fence(__ATOMIC_ACQUIRE, "agent");
            asm volatile("s_waitcnt vmcnt(0)" ::: "memory");
        }
    }
    __syncthreads();
}

#ifndef PHASE_MASK
#define PHASE_MASK 0xffffu
#endif
#define PH(n) (((PHASE_MASK) >> (n)) & 1u)
struct Params { const float* in[24]; float* out; unsigned char* ws; };

__global__ void __launch_bounds__(NTHREADS, 2) fwd_megakernel(Params p) {
    extern __shared__ __attribute__((aligned(16))) unsigned char lds_raw[];
    LAS unsigned char* lds = (LAS unsigned char*)lds_raw;
    cg::grid_group grid = cg::this_grid();
    const int tid = threadIdx.x, lane = tid & 63, wave = __builtin_amdgcn_readfirstlane(tid >> 6);
    const int G = gridDim.x, bx = blockIdx.x;
    const int gw = bx * NWAVES + wave, NGW = G * NWAVES;
    unsigned char* ws = p.ws;
    const float* x = p.in[0];
    float* out = p.out;
    bf16_t* Wgu1 = (bf16_t*)(ws + WS_WGU1); bf16_t* Wd1 = (bf16_t*)(ws + WS_WD1); bf16_t* Win = (bf16_t*)(ws + WS_WIN); bf16_t* Wa = (bf16_t*)(ws + WS_WA); bf16_t* Wb = (bf16_t*)(ws + WS_WB);
    bf16_t* Wout = (bf16_t*)(ws + WS_WOUT); bf16_t* Wgu2 = (bf16_t*)(ws + WS_WGU2); bf16_t* Wd2 = (bf16_t*)(ws + WS_WD2); bf16_t* Wsb = (bf16_t*)(ws + WS_WSB);
    bf16_t* XB = (bf16_t*)(ws + WS_XB); bf16_t* Hb = (bf16_t*)(ws + WS_H); bf16_t* Ub = (bf16_t*)(ws + WS_U); bf16_t* Vb = (bf16_t*)(ws + WS_V); bf16_t* Zb = (bf16_t*)(ws + WS_Z);
    bf16_t* Gb = (bf16_t*)(ws + WS_G); bf16_t* Bo = (bf16_t*)(ws + WS_BOUT);
    float* stash = (float*)(ws + WS_STASH) + (size_t)bx * 65536;
    f32x2* stats1 = (f32x2*)(ws + WS_CTL + 65536); f32x2* stats2 = (f32x2*)(ws + WS_CTL + 524288);
    volatile LAS unsigned* bst = (volatile LAS unsigned*)(lds + 131072 + 320);
    if (tid < 4) bst[tid] = 0u;
    __syncthreads();
    const XcdBarrier xbar = xcd_barrier_post((unsigned*)(ws + WS_CTL), bst);
#define GRID_BAR() xcd_barrier(xbar)

    if (PH(0)) {
        LAS float* scr = (LAS float*)(lds + wave * 16384);
        p0_matrix(p.in[1], DM, 2 * FF, Wgu1, 1, scr, gw, NGW, lane);
        p0_matrix(p.in[2], FF, DM, Wd1, 0, scr, gw, NGW, lane);
        p0_matrix(p.in[5], DM, INC, Win, 2, scr, gw, NGW, lane);
        p0_matrix(p.in[11], AW, DM, Wa, 0, scr, gw, NGW, lane);
        p0_matrix(p.in[16], AW, DM, Wb, 0, scr, gw, NGW, lane);
        p0_matrix(p.in[17], DM, DM, Wout, 0, scr, gw, NGW, lane);
        p0_matrix(p.in[20], DM, 2 * FF, Wgu2, 1, scr, gw, NGW, lane);
        p0_matrix(p.in[21], FF, DM, Wd2, 0, scr, gw, NGW, lane);
        const size_t gt = (size_t)bx * NTHREADS + tid, GT = (size_t)G * NTHREADS;
        for (size_t i = gt; i < (size_t)MTOK * DM / 8; i += 4 * GT) {
            f32x4 a[4], b[4];
#pragma unroll
            for (int u = 0; u < 4; ++u) { const size_t ii = i + u * GT; if (ii < (size_t)MTOK * DM / 8) { a[u] = ((const f32x4*)x)[2 * ii]; b[u] = ((const f32x4*)x)[2 * ii + 1]; } }
#pragma unroll
            for (int u = 0; u < 4; ++u) { const size_t ii = i + u * GT; if (ii < (size_t)MTOK * DM / 8) {
                u32x4 w; w.x = cvt_pk_bf16(a[u][0], a[u][1]); w.y = cvt_pk_bf16(a[u][2], a[u][3]); w.z = cvt_pk_bf16(b[u][0], b[u][1]); w.w = cvt_pk_bf16(b[u][2], b[u][3]);
                ((u32x4*)XB)[ii] = w; } }
        }
        const float* wsf = p.in[9];
        for (size_t i = gt; i < (size_t)8 * 128 * 128 / 2; i += GT) {
            const int jj = (int)((2 * i) & 127), ii = (int)(((2 * i) >> 7) & 127);
            const f32x2 v = ((const f32x2*)wsf)[i];
            const bool keep = !(ii < 64 && jj >= 64);
            ((unsigned*)Wsb)[i] = keep ? cvt_pk_bf16(v[0], v[1]) : 0u;
        }
    }
    grid.sync();
    if (PH(1)) { pg8::Gemm g{XB, Wgu1, nullptr, nullptr, MTOK, 2 * FF, DM}; pg8::StaticOrder S; S.init(MTOK, 2 * FF, G, bx); pg8::EpiSwiGLU E{Hb}; pg8::gemm_phase(lds, g, S, E); }
    GRID_BAR();
    if (PH(2)) { pg8::Gemm g{Hb, Wd1, nullptr, nullptr, MTOK, DM, FF}; pg8::StaticOrder S; S.init(MTOK, DM, G, bx); pg8::EpiRes<false> E{x, nullptr, nullptr, nullptr, out, ALPHA, 0.5f}; pg8::gemm_phase(lds, g, S, E); }
    GRID_BAR();
    if (PH(3)) ln_phase(out, nullptr, XB, stats1, p.in[3], p.in[4], gw, NGW, lane);
    GRID_BAR();
    if (PH(4)) { pg8::Gemm g{XB, Win, nullptr, nullptr, MTOK, INC, DM}; pg8::StaticOrder S; S.init(MTOK, INC, G, bx); pg8::EpiProj E{p.in[6], Ub, Vb, Zb, Gb}; pg8::gemm_phase(lds, g, S, E); }
    GRID_BAR();
    if (PH(5)) for (int blk = bx; blk < MTOK / 128; blk += G) sgu_item(lds, Vb, Ub, Wsb, p.in[10], p.in[7], p.in[8], blk, tid, wave, lane);
    __syncthreads();
    if (PH(6)) conv_items(lds, Zb, Bo, p.in[12], p.in[13], p.in[14], p.in[15], bx, G, tid, wave, lane);
    GRID_BAR();
    if (PH(7)) { pg8::Gemm g{Ub, Wa, Bo, Wb, MTOK, DM, AW}; pg8::DualOrder S; S.init(MTOK, DM, G, bx); pg8::EpiMix E{Gb, XB, stash}; pg8::gemm_phase(lds, g, S, E); }
    GRID_BAR();
    if (PH(8)) { pg8::Gemm g{XB, Wout, nullptr, nullptr, MTOK, DM, DM}; pg8::StaticOrder S; S.init(MTOK, DM, G, bx); pg8::EpiRes<true> E{out, stats1, p.in[3], p.in[4], out, ALPHA, 1.0f}; pg8::gemm_phase(lds, g, S, E); }
    GRID_BAR();
    if (PH(9)) ln_phase(out, nullptr, XB, stats2, p.in[18], p.in[19], gw, NGW, lane);
    GRID_BAR();
    if (PH(10)) { pg8::Gemm g{XB, Wgu2, nullptr, nullptr, MTOK, 2 * FF, DM}; pg8::StaticOrder S; S.init(MTOK, 2 * FF, G, bx); pg8::EpiSwiGLU E{Hb}; pg8::gemm_phase(lds, g, S, E); }
    GRID_BAR();
    if (PH(11)) { pg8::Gemm g{Hb, Wd2, nullptr, nullptr, MTOK, DM, FF}; pg8::StaticOrder S; S.init(MTOK, DM, G, bx); pg8::EpiRes<true> E{out, stats2, p.in[18], p.in[19], out, ALPHA, 0.5f}; pg8::gemm_phase(lds, g, S, E); }
    GRID_BAR();
    if (PH(12)) ln_phase(out, out, nullptr, nullptr, p.in[22], p.in[23], gw, NGW, lane);
}

extern "C" void kernel_launch(void* const* d_in, const int* in_sizes, int n_in, void* d_out, int out_size, void* d_ws, size_t ws_size, hipStream_t stream) {
    static int grid_blocks = 0;
    if (grid_blocks == 0) {
        if (n_in != 24 || out_size != MTOK * DM || ws_size < WS_END) { fprintf(stderr, "kernel_launch: unexpected shapes: n_in %d out %d ws %zu\n", n_in, out_size, ws_size); grid_blocks = -1; return; }
        int dev = 0, cus = 0, per_cu = 0;
        (void)hipGetDevice(&dev);
        (void)hipDeviceGetAttribute(&cus, hipDeviceAttributeMultiprocessorCount, dev);
        if (hipFuncSetAttribute((const void*)fwd_megakernel, hipFuncAttributeMaxDynamicSharedMemorySize, LDS_BYTES) != hipSuccess) { fprintf(stderr, "kernel_launch: hipFuncSetAttribute failed\n"); grid_blocks = -1; return; }
        if (hipOccupancyMaxActiveBlocksPerMultiprocessor(&per_cu, (const void*)fwd_megakernel, NTHREADS, LDS_BYTES) != hipSuccess || per_cu < 1) { fprintf(stderr, "kernel_launch: occupancy query gave %d\n", per_cu); per_cu = 1; (void)hipGetLastError(); }
        grid_blocks = cus * per_cu;
    }
    if (grid_blocks < 0) return;
    if (hipMemsetAsync((char*)d_ws + WS_CTL, 0, CTL_BYTES, stream) != hipSuccess) { fprintf(stderr, "kernel_launch: memset failed\n"); return; }
    Params p{};
    for (int i = 0; i < 24; ++i) p.in[i] = (const float*)d_in[i];
    p.out = (float*)d_out; p.ws = (unsigned char*)d_ws;
    void* args[] = {&p};
    hipError_t e = hipLaunchCooperativeKernel((const void*)fwd_megakernel, dim3(grid_blocks), dim3(NTHREADS), args, LDS_BYTES, stream);
    if (e != hipSuccess) fprintf(stderr, "kernel_launch: cooperative launch failed: %s (grid %d)\n", hipGetErrorString(e), grid_blocks);
}
```
